# Optimizing an MI355X kernel written in HIP

```python
import math
import jax, jax.numpy as jnp
from jax import lax
import numpy as np

D_MODEL = 1024
BATCH = 32
SEQ = 2048
DEPTH = 2

CHUNK = 64
Q_BLOCK = 128
HEAD_DIM = 64
N_HEADS = D_MODEL // HEAD_DIM
N_GROUPS = 4
HEADS_PER_GROUP = N_HEADS // N_GROUPS
GROUP_WIDTH = HEADS_PER_GROUP * HEAD_DIM
MIX_WIDTH = N_GROUPS * GROUP_WIDTH
BAND_CHUNKS = 8
BAND = (BAND_CHUNKS + 1) * CHUNK
MAX_REL_DIST = 256
N_REL = 2 * MAX_REL_DIST + 1
DIFF_QK_DIM = HEAD_DIM // 2
D_FF = ((8 * D_MODEL // 3 + 255) // 256) * 256
FFN_RES = 0.5
RMS_EPS = 1e-6
GROUP_SPLIT_SIZES = (GROUP_WIDTH, GROUP_WIDTH, GROUP_WIDTH, HEADS_PER_GROUP,
                     GROUP_WIDTH, GROUP_WIDTH, GROUP_WIDTH,
                     GROUP_WIDTH, GROUP_WIDTH, GROUP_WIDTH,
                     GROUP_WIDTH, GROUP_WIDTH, GROUP_WIDTH)
IN_WIDTH = 12 * GROUP_WIDTH + HEADS_PER_GROUP

kernel_name = 'hybrid_chunk_causal_parallel_heads'


def _split_points():
    return [int(p) for p in np.cumsum(GROUP_SPLIT_SIZES)[:-1]]


def rmsnorm(x, g):
    xf = x.astype(jnp.float32)
    y = xf * lax.rsqrt(jnp.mean(xf * xf, axis=-1, keepdims=True) + RMS_EPS)
    return (y * g.astype(jnp.float32)).astype(x.dtype)


def swiglu(h, w_gu, w_down):
    gate, up = jnp.split(h @ w_gu, 2, axis=-1)
    return (jax.nn.silu(gate) * up) @ w_down


def to_heads(t):
    b, s, w = t.shape
    return t.reshape(b, s, w // HEAD_DIM, HEAD_DIM).transpose(0, 2, 1, 3)


def from_heads(t):
    b, h, s, d = t.shape
    return t.transpose(0, 2, 1, 3).reshape(b, s, h * d)


def alibi_slopes(n):
    return jnp.asarray([2.0 ** (-8.0 * (i + 1) / n) for i in range(n)], dtype=jnp.float32)


def lambda_init(layer_idx):
    return 0.8 - 0.6 * math.exp(-0.3 * layer_idx)


def forgetting_attention(q, k, v, log_f):
    seq, d = q.shape[2], q.shape[3]
    scale = d ** -0.5
    cum_f = jnp.cumsum(log_f, axis=-1)
    outs = []
    for i in range(seq // Q_BLOCK):
        q0, q1 = i * Q_BLOCK, (i + 1) * Q_BLOCK
        logits = jnp.einsum('bhqd,bhkd->bhqk', q[:, :, q0:q1], k[:, :, :q1]).astype(jnp.float32) * scale
        logits = logits + cum_f[:, :, q0:q1, None] - cum_f[:, :, None, :q1]
        t = jnp.arange(q0, q1)[:, None]
        s = jnp.arange(q1)[None, :]
        logits = jnp.where(s <= t, logits, -jnp.inf)
        p = jax.nn.softmax(logits, axis=-1)
        outs.append(jnp.einsum('bhqk,bhkd->bhqd', p.astype(v.dtype), v[:, :, :q1]))
    return jnp.concatenate(outs, axis=2)


def chunked_relpos_attention(q, k, v, rel_table):
    b, h, seq, d = q.shape
    scale = d ** -0.5
    n_chunks = seq // CHUNK
    pad = BAND_CHUNKS * CHUNK
    kp = jnp.pad(k, ((0, 0), (0, 0), (pad, 0), (0, 0)))
    vp = jnp.pad(v, ((0, 0), (0, 0), (pad, 0), (0, 0)))
    rel = pad + np.arange(CHUNK)[:, None] - np.arange(BAND)[None, :]
    rel_idx = np.clip(rel, -MAX_REL_DIST, MAX_REL_DIST) + MAX_REL_DIST
    bias = rel_table.astype(jnp.float32)[:, rel_idx]

    def chunk_fn(c):
        qc = lax.dynamic_slice_in_dim(q, c * CHUNK, CHUNK, axis=2)
        kc = lax.dynamic_slice_in_dim(kp, c * CHUNK, BAND, axis=2)
        vc = lax.dynamic_slice_in_dim(vp, c * CHUNK, BAND, axis=2)
        logits = jnp.einsum('bhqd,bhkd->bhqk', qc, kc).astype(jnp.float32) * scale + bias
        key_pos = c * CHUNK - pad + jnp.arange(BAND)
        logits = jnp.where(key_pos >= 0, logits, -jnp.inf)
        p = jax.nn.softmax(logits, axis=-1)
        return jnp.einsum('bhqk,bhkd->bhqd', p.astype(v.dtype), vc)

    out = lax.map(chunk_fn, jnp.arange(n_chunks))
    return out.transpose(1, 2, 0, 3, 4).reshape(b, h, seq, d)


def diff_attention(q, k, v, lam_params, lam_init):
    seq = q.shape[2]
    q1, q2 = q[..., :DIFF_QK_DIM], q[..., DIFF_QK_DIM:]
    k1, k2 = k[..., :DIFF_QK_DIM], k[..., DIFF_QK_DIM:]
    lp = lam_params.astype(jnp.float32)
    lam = jnp.exp(jnp.sum(lp[0] * lp[1])) - jnp.exp(jnp.sum(lp[2] * lp[3])) + lam_init
    scale = DIFF_QK_DIM ** -0.5
    slopes = alibi_slopes(q.shape[1])[:, None, None]
    outs = []
    for i in range(seq // Q_BLOCK):
        q0, q1e = i * Q_BLOCK, (i + 1) * Q_BLOCK
        t = jnp.arange(q0, q1e)[:, None]
        s = jnp.arange(q1e)[None, :]
        alibi = -slopes * jnp.abs(t - s).astype(jnp.float32)
        mask = (s // CHUNK) <= (t // CHUNK)
        l1 = jnp.einsum('bhqd,bhkd->bhqk', q1[:, :, q0:q1e], k1[:, :, :q1e]).astype(jnp.float32) * scale + alibi
        l2 = jnp.einsum('bhqd,bhkd->bhqk', q2[:, :, q0:q1e], k2[:, :, :q1e]).astype(jnp.float32) * scale + alibi
        p = (jax.nn.softmax(jnp.where(mask, l1, -jnp.inf), axis=-1)
             - lam * jax.nn.softmax(jnp.where(mask, l2, -jnp.inf), axis=-1))
        outs.append(jnp.einsum('bhqk,bhkd->bhqd', p.astype(v.dtype), v[:, :, :q1e]))
    o = jnp.concatenate(outs, axis=2).astype(jnp.float32)
    o = o * lax.rsqrt(jnp.mean(o * o, axis=-1, keepdims=True) + RMS_EPS) * (1.0 - lam_init)
    return o.astype(v.dtype)


def stick_breaking_attention(q, k, v):
    seq, d = q.shape[2], q.shape[3]
    scale = d ** -0.5
    outs = []
    for i in range(seq // Q_BLOCK):
        q0, q1 = i * Q_BLOCK, (i + 1) * Q_BLOCK
        z = jnp.einsum('bhqd,bhkd->bhqk', q[:, :, q0:q1], k[:, :, :q1]).astype(jnp.float32) * scale
        t = jnp.arange(q0, q1)[:, None]
        s = jnp.arange(q1)[None, :]
        strict = s < t
        log_one_minus = jnp.where(strict, jax.nn.log_sigmoid(-z), 0.0)
        suffix = lax.cumsum(log_one_minus, axis=3, reverse=True) - log_one_minus
        weights = jnp.where(strict, jnp.exp(jax.nn.log_sigmoid(z) + suffix), 0.0)
        outs.append(jnp.einsum('bhqk,bhkd->bhqd', weights.astype(v.dtype), v[:, :, :q1]))
    return jnp.concatenate(outs, axis=2)


def hybrid_mixer(h, w_in, b_f, rel_table, lam_params, w_out, lam_init):
    proj = h @ w_in
    (qa, ka, va, fa, qb, kb, vb, qc, kc, vc, qd, kd, vd) = jnp.split(proj, _split_points(), axis=-1)
    log_f = jax.nn.log_sigmoid((fa + b_f).astype(jnp.float32)).transpose(0, 2, 1)
    o_a = forgetting_attention(to_heads(qa), to_heads(ka), to_heads(va), log_f)
    o_b = chunked_relpos_attention(to_heads(qb), to_heads(kb), to_heads(vb), rel_table)
    o_c = diff_attention(to_heads(qc), to_heads(kc), to_heads(vc), lam_params, lam_init)
    o_d = stick_breaking_attention(to_heads(qd), to_heads(kd), to_heads(vd))
    mixed = jnp.concatenate([from_heads(o_a), from_heads(o_b), from_heads(o_c), from_heads(o_d)], axis=-1)
    return mixed @ w_out


def setup_inputs(seed: int = 0) -> dict:
    key = jax.random.key(seed)
    ks = jax.random.split(key, 16)
    f32 = jnp.float32
    x = jax.random.normal(ks[0], (BATCH, SEQ, D_MODEL), f32)
    g_ffn1 = 1.0 + 0.02 * jax.random.normal(ks[1], (DEPTH, D_MODEL), f32)
    ffn1_w_gu = jax.random.normal(ks[2], (DEPTH, D_MODEL, 2 * D_FF), f32) * D_MODEL ** -0.5
    ffn1_w_down = jax.random.normal(ks[3], (DEPTH, D_FF, D_MODEL), f32) * D_FF ** -0.5
    g_mix = 1.0 + 0.02 * jax.random.normal(ks[4], (DEPTH, D_MODEL), f32)
    w_in = jax.random.normal(ks[5], (DEPTH, D_MODEL, IN_WIDTH), f32) * D_MODEL ** -0.5
    b_f = 0.1 * jax.random.normal(ks[6], (DEPTH, HEADS_PER_GROUP), f32)
    rel_bias = 0.2 * jax.random.normal(ks[7], (DEPTH, HEADS_PER_GROUP, N_REL), f32)
    diff_lambda = 0.1 * jax.random.normal(ks[8], (DEPTH, 4, DIFF_QK_DIM), f32)
    w_out = jax.random.normal(ks[9], (DEPTH, MIX_WIDTH, D_MODEL), f32) * MIX_WIDTH ** -0.5
    g_ffn2 = 1.0 + 0.02 * jax.random.normal(ks[10], (DEPTH, D_MODEL), f32)
    ffn2_w_gu = jax.random.normal(ks[11], (DEPTH, D_MODEL, 2 * D_FF), f32) * D_MODEL ** -0.5
    ffn2_w_down = jax.random.normal(ks[12], (DEPTH, D_FF, D_MODEL), f32) * D_FF ** -0.5
    g_final = 1.0 + 0.02 * jax.random.normal(ks[13], (D_MODEL,), f32)
    return {'x': x, 'g_ffn1': g_ffn1, 'ffn1_w_gu': ffn1_w_gu, 'ffn1_w_down': ffn1_w_down,
            'g_mix': g_mix, 'w_in': w_in, 'b_f': b_f, 'rel_bias': rel_bias,
            'diff_lambda': diff_lambda, 'w_out': w_out, 'g_ffn2': g_ffn2,
            'ffn2_w_gu': ffn2_w_gu, 'ffn2_w_down': ffn2_w_down, 'g_final': g_final}


def reference(x, g_ffn1, ffn1_w_gu, ffn1_w_down, g_mix, w_in, b_f, rel_bias, diff_lambda,
              w_out, g_ffn2, ffn2_w_gu, ffn2_w_down, g_final):
    for l in range(DEPTH):
        x = x + FFN_RES * swiglu(rmsnorm(x, g_ffn1[l]), ffn1_w_gu[l], ffn1_w_down[l])
        x = x + hybrid_mixer(rmsnorm(x, g_mix[l]), w_in[l], b_f[l], rel_bias[l], diff_lambda[l],
                             w_out[l], lambda_init(l))
        x = x + FFN_RES * swiglu(rmsnorm(x, g_ffn2[l]), ffn2_w_gu[l], ffn2_w_down[l])
    return rmsnorm(x, g_final)
```

```cpp
#include <hip/hip_runtime.h>
#include <hip/hip_cooperative_groups.h>
#include <cstdio>
#include <cstdint>
namespace cg = cooperative_groups;
constexpr int DM = 1024, BATCH = 32, SEQ = 2048, MROWS = BATCH * SEQ, DFF = 2816, NGU = 2 * DFF, NIN = 3072, INW = 3076, NREL = 513;
constexpr float RMS_EPS = 1e-6f, LOG2E = 1.4426950408889634f;

#ifndef PG8_WGM
#define PG8_WGM 8
#endif
namespace pg8 {
#define PG8_LAS __attribute__((address_space(3)))
typedef unsigned short bf16_t;
typedef short bf16x8 __attribute__((ext_vector_type(8)));
typedef float f32x4 __attribute__((ext_vector_type(4)));
typedef unsigned u32x4 __attribute__((ext_vector_type(4)));
constexpr int BM = 256, BK = 64, HALF = 128, HTB = HALF * BK * 2  , STAGE_BYTES = 8 * HTB, NXCD = 8, WGM = PG8_WGM;

__host__ __device__ __forceinline__ int lds_byte(int r, int c) { const int st = (r >> 4) * 2 + (c >> 5), rr = r & 15, cc = c & 31, ob = rr * 64 + cc * 2; return st * 1024 + (ob ^ (((ob >> 9) & 1) << 5)); }
__host__ __device__ __forceinline__ void stage_rc(int b, int& R, int& C) { const int st = b / 1024, sb = b % 1024, swz = sb ^ (((sb >> 9) & 1) << 5); R = (st >> 1) * 16 + swz / 64; C = (st & 1) * 32 + (swz % 64) / 2; }
__host__ __device__ __forceinline__ int perm32(int rho) { const int n = rho >> 4, i = rho & 15; return 8 * (i >> 2) + 4 * n + (i & 3); }

struct Unit { int pm, pn, pass; };
struct Gemm { const bf16_t* A; const bf16_t* Bt; int M, N, K; };

struct StaticOrder {
    int nM, nN, nwg, G, c, rep = 1;
    __host__ __device__ void init(int M, int N, int G_, int c_) { nM = M / BM; nN = N / BM; nwg = nM * nN; G = G_; c = c_; }
    __host__ __device__ bool next(int i, Unit& u) const {
        const long L = (long)i * G + c; if (L >= (long)nwg * rep) return false;
        int wgid = (int)(L % nwg); u.pass = (int)(L / nwg); { const int q = nwg / NXCD, r = nwg % NXCD, xcd = wgid % NXCD, off = wgid / NXCD; wgid = (xcd < r ? xcd * (q + 1) : r * (q + 1) + (xcd - r) * q) + off; }
        const int nig = WGM * nN, gid = wgid / nig, fm = gid * WGM, gsz = (nM - fm) < WGM ? (nM - fm) : WGM;
        u.pm = fm + ((wgid % nig) % gsz); u.pn = (wgid % nig) / gsz; return true;
    }
    __device__ __forceinline__ void a_ready(const Unit&) const {}
    __device__ __forceinline__ void done(const Unit&) const {}
};

__device__ __forceinline__ unsigned cvt_pk_bf16(float lo, float hi) { unsigned r; asm volatile("v_cvt_pk_bf16_f32 %0, %1, %2" : "=v"(r) : "v"(lo), "v"(hi)); return r; }
__device__ __forceinline__ float fq_sum(float v) {
    auto a = __builtin_amdgcn_permlane16_swap(__float_as_uint(v), __float_as_uint(v), false, false);
    const float s = __uint_as_float(a[0]) + __uint_as_float(a[1]);
    auto b = __builtin_amdgcn_permlane32_swap(__float_as_uint(s), __float_as_uint(s), false, false);
    return __uint_as_float(b[0]) + __uint_as_float(b[1]);
}
__device__ __forceinline__ float row_rs(const float* SS, int row, int fq) {
    const f32x4 sv = *(const f32x4*)(SS + (size_t)row * 16 + 4 * fq);
    float s = (sv[0] + sv[1]) + (sv[2] + sv[3]);
    s += __shfl_xor(s, 16); s += __shfl_xor(s, 32);
    return __builtin_amdgcn_rsqf(s * (1.0f / DM) + RMS_EPS);
}
__device__ __forceinline__ void row_rs8(const float* SS, int row0, int fq, float (&rs)[2][4]) {
    f32x4 sv[2][4];
#pragma unroll
    for (int ai = 0; ai < 2; ++ai)
#pragma unroll
        for (int m = 0; m < 4; ++m) sv[ai][m] = *(const f32x4*)(SS + (size_t)(row0 + ai * HALF + m * 16) * 16 + 4 * fq);
#pragma unroll
    for (int ai = 0; ai < 2; ++ai)
#pragma unroll
        for (int m = 0; m < 4; ++m) {
            float s = (sv[ai][m][0] + sv[ai][m][1]) + (sv[ai][m][2] + sv[ai][m][3]);
            s += __shfl_xor(s, 16); s += __shfl_xor(s, 32);
            rs[ai][m] = __builtin_amdgcn_rsqf(s * (1.0f / DM) + RMS_EPS);
        }
    asm volatile("" ::: "memory");
}
__device__ __forceinline__ void row_rs8_lds(const PG8_LAS unsigned char* rsl, int rowl0, int fq, float (&rs)[2][4]) {
    f32x4 sv[2][4];
#pragma unroll
    for (int ai = 0; ai < 2; ++ai)
#pragma unroll
        for (int m = 0; m < 4; ++m) sv[ai][m] = *(const PG8_LAS f32x4*)(rsl + (rowl0 + ai * HALF + m * 16) * 64 + fq * 16);
#pragma unroll
    for (int ai = 0; ai < 2; ++ai)
#pragma unroll
        for (int m = 0; m < 4; ++m) rs[ai][m] = __builtin_amdgcn_rsqf(fq_sum((sv[ai][m][0] + sv[ai][m][1]) + (sv[ai][m][2] + sv[ai][m][3])) * (1.0f / DM) + RMS_EPS);
}
__device__ __forceinline__ void stage_rs_lds(const float* SS, PG8_LAS unsigned char* rsl, const Unit& u, int tid, int wid) {
    const int lane = tid & 63;
#pragma unroll
    for (int j = 0; j < 2; ++j) {
        const float* src = SS + (size_t)(u.pm * BM + 32 * wid + 16 * j + (lane >> 2)) * 16 + 4 * (lane & 3);
        __builtin_amdgcn_global_load_lds((const unsigned*)src, (PG8_LAS unsigned*)(rsl + (2 * wid + j) * 1024), 16, 0, 0);
    }
}
struct EpiGU {
    static constexpr bool PERM = true, AFTER_DRAIN = false, PREFETCH = false, IDEMPOTENT = true, RS_LDS = true;
    bf16_t* O; const float* SS; PG8_LAS unsigned char* rsl;
    __device__ __forceinline__ void stage_rs(const Unit& u, int tid, int wid) const { stage_rs_lds(SS, rsl, u, tid, wid); }
    __device__ __forceinline__ void operator()(const f32x4 (&acc)[2][2][4][2], const Unit& u, int wr, int wc, int fr, int fq) const {
        const int row0 = u.pm * BM + wr * 64 + fr, col0 = u.pn * 128 + wc * 32 + 8 * fq;
        float rsv[2][4]; row_rs8_lds(rsl, wr * 64 + fr, fq, rsv);
#pragma unroll
        for (int ai = 0; ai < 2; ++ai)
#pragma unroll
            for (int m = 0; m < 4; ++m) {
                const int row = row0 + ai * HALF + m * 16;
                const float rs = rsv[ai][m];
                f32x4 av[2];
#pragma unroll
                for (int n = 0; n < 2; ++n) {
                    const f32x4 g = acc[ai][0][m][n] * rs, up = acc[ai][1][m][n] * rs, t = g * (-LOG2E);
                    f32x4 d; d[0] = __builtin_amdgcn_exp2f(t[0]); d[1] = __builtin_amdgcn_exp2f(t[1]); d[2] = __builtin_amdgcn_exp2f(t[2]); d[3] = __builtin_amdgcn_exp2f(t[3]);
                    d = d + 1.0f;
                    f32x4 r; r[0] = __builtin_amdgcn_rcpf(d[0]); r[1] = __builtin_amdgcn_rcpf(d[1]); r[2] = __builtin_amdgcn_rcpf(d[2]); r[3] = __builtin_amdgcn_rcpf(d[3]);
                    av[n] = (g * up) * r;
                }
                u32x4 w; w.x = cvt_pk_bf16(av[0][0], av[0][1]); w.y = cvt_pk_bf16(av[0][2], av[0][3]); w.z = cvt_pk_bf16(av[1][0], av[1][1]); w.w = cvt_pk_bf16(av[1][2], av[1][3]);
                *(u32x4*)(O + (size_t)row * DFF + col0) = w;
            }
    }
};
struct EpiQKV {
    static constexpr bool PERM = true, AFTER_DRAIN = false, PREFETCH = false, IDEMPOTENT = true, RS_LDS = true;
    bf16_t* O; const float* SS; PG8_LAS unsigned char* rsl; unsigned* KM;
    __device__ __forceinline__ void stage_rs(const Unit& u, int tid, int wid) const { stage_rs_lds(SS, rsl, u, tid, wid); }
    __device__ __forceinline__ void operator()(const f32x4 (&acc)[2][2][4][2], const Unit& u, int wr, int wc, int fr, int fq) const {
        const int row0 = u.pm * BM + wr * 64 + fr, col0 = u.pn * BM + wc * 32 + 8 * fq;
        float cs = 1.0f;
        if (u.pn % 3 == 0) cs = (u.pn == 6) ? 0.17677669529663687f * LOG2E : 0.125f * LOG2E;
        float rsv[2][4]; row_rs8_lds(rsl, wr * 64 + fr, fq, rsv);
        const bool kn = (u.pn == 1) || (u.pn == 7);
        float mx[2] = {0.f, 0.f};
#pragma unroll
        for (int ai = 0; ai < 2; ++ai)
#pragma unroll
            for (int m = 0; m < 4; ++m) {
                const int row = row0 + ai * HALF + m * 16;
                const float rs = rsv[ai][m] * cs;
#pragma unroll
                for (int bj = 0; bj < 2; ++bj) {
                    const f32x4 v0 = acc[ai][bj][m][0] * rs, v1 = acc[ai][bj][m][1] * rs;
                    if (kn) { const float ss = fq_sum(((v0[0] * v0[0] + v0[1] * v0[1]) + (v0[2] * v0[2] + v0[3] * v0[3])) + ((v1[0] * v1[0] + v1[1] * v1[1]) + (v1[2] * v1[2] + v1[3] * v1[3]))); mx[bj] = fmaxf(mx[bj], ss); }
                    u32x4 w; w.x = cvt_pk_bf16(v0[0], v0[1]); w.y = cvt_pk_bf16(v0[2], v0[3]); w.z = cvt_pk_bf16(v1[0], v1[1]); w.w = cvt_pk_bf16(v1[2], v1[3]);
                    *(u32x4*)(O + (size_t)row * NIN + col0 + bj * HALF) = w;
                }
            }
        if (kn) {
#pragma unroll
            for (int bj = 0; bj < 2; ++bj) {
                float v = mx[bj];
#pragma unroll
                for (int o = 1; o < 16; o <<= 1) v = fmaxf(v, __shfl_xor(v, o));
                if (fr == 0 && fq == 0) atomicMax(KM + ((((u.pn == 7) ? 32 : 0) + (u.pm >> 3)) * 4 + 2 * bj + (wc >> 1)) * 2 + (wc & 1), __float_as_uint(v));
            }
        }
    }
};
struct EpiRes {
    static constexpr bool PERM = true, AFTER_DRAIN = false, PREFETCH = false, IDEMPOTENT = false, RS_LDS = false;
    bf16_t* xb; float* SS; float alpha;
    __device__ __forceinline__ void operator()(const f32x4 (&acc)[2][2][4][2], const Unit& u, int wr, int wc, int fr, int fq) const {
        const int row0 = u.pm * BM + wr * 64 + fr, col0 = u.pn * BM + wc * 32 + 8 * fq;
        const float alpha = (u.pass & 1) ? -this->alpha : this->alpha;
#pragma unroll
        for (int ai = 0; ai < 2; ++ai) {
            u32x4 bb[4][2];
#pragma unroll
            for (int m = 0; m < 4; ++m)
#pragma unroll
                for (int bj = 0; bj < 2; ++bj) bb[m][bj] = *(const u32x4*)(xb + (size_t)(row0 + ai * HALF + m * 16) * DM + col0 + bj * HALF);
            asm volatile("" ::: "memory");
#pragma unroll
            for (int m = 0; m < 4; ++m) {
                const int row = row0 + ai * HALF + m * 16;
                bf16_t* xp = xb + (size_t)row * DM + col0;
                float ssq = 0.f;
#pragma unroll
                for (int bj = 0; bj < 2; ++bj) {
                    const u32x4 b = bb[m][bj];
                    float v[8];
#pragma unroll
                    for (int j = 0; j < 4; ++j) {
                        v[2 * j] = __uint_as_float(b[j] << 16) + acc[ai][bj][m][j >> 1][(2 * j) & 3] * alpha;
                        v[2 * j + 1] = __uint_as_float(b[j] & 0xffff0000u) + acc[ai][bj][m][j >> 1][(2 * j + 1) & 3] * alpha;
                    }
                    u32x4 w; w.x = cvt_pk_bf16(v[0], v[1]); w.y = cvt_pk_bf16(v[2], v[3]); w.z = cvt_pk_bf16(v[4], v[5]); w.w = cvt_pk_bf16(v[6], v[7]);
                    *(u32x4*)(xp + bj * HALF) = w;
#pragma unroll
                    for (int j = 0; j < 4; ++j) { const float r0 = __uint_as_float(w[j] << 16), r1 = __uint_as_float(w[j] & 0xffff0000u); ssq += r0 * r0 + r1 * r1; }
                }
                ssq = fq_sum(ssq);
                if (fq == 0) SS[(size_t)row * 16 + u.pn * 4 + wc] = ssq;
            }
        }
    }
};
template <class Epi, class Sched, bool ALIGN_EPI = false, bool SP2 = false>
__device__ __forceinline__ void gemm_phase(PG8_LAS unsigned char* lds, const Gemm g, const Sched& S, const Epi& E, const int tid) {
    const int wid = __builtin_amdgcn_readfirstlane(tid >> 6), lane = tid & 63, wr = wid >> 2, wc = wid & 3, fr = lane & 15, fq = lane >> 4;
    const int K = g.K, nt = K / BK;
    unsigned voffA[2], voffB[2];
#pragma unroll
    for (int i = 0; i < 2; ++i) { int R, C; stage_rc(tid * 16 + i * 8192, R, C); const int Rb = Epi::PERM ? ((R & ~31) + perm32(R & 31)) : R;
        voffA[i] = (unsigned)(R * K + C) * 2u; voffB[i] = (unsigned)(Rb * K + C) * 2u; }
    const size_t kstep = (size_t)(BK * 2);
    const size_t hstep = (size_t)HALF * K * 2;
    const size_t tstep = 2 * hstep;
    const unsigned ldsw = (unsigned)wid * 1024u;
    const int aoff = lds_byte(wr * 64 + fr, fq * 8), boff = lds_byte(wc * 32 + fr, fq * 8);
#define PG8_SA(b, h) (((b) * 2 + (h)) * HTB)
#define PG8_SB(b, h) ((4 + (b) * 2 + (h)) * HTB)
#define PG8_STAGE(bufoff, gbase, voff) do { _Pragma("unroll") for (int _i = 0; _i < 2; ++_i) \
        __builtin_amdgcn_global_load_lds((const unsigned*)((const char*)(gbase) + (voff)[_i]), (PG8_LAS unsigned*)(lds + (bufoff) + ldsw + _i * 8192), 16, 0, 0); } while (0)
#define PG8_LDA(dst, b, h) do { _Pragma("unroll") for (int m = 0; m < 4; ++m) _Pragma("unroll") for (int k = 0; k < 2; ++k) dst[m][k] = *(const PG8_LAS bf16x8*)(lds + PG8_SA(b, h) + aoff + m * 2048 + k * 1024); } while (0)
#define PG8_LDB(dst, b, h) do { _Pragma("unroll") for (int n = 0; n < 2; ++n) _Pragma("unroll") for (int k = 0; k < 2; ++k) dst[n][k] = *(const PG8_LAS bf16x8*)(lds + PG8_SB(b, h) + boff + n * 2048 + k * 1024); } while (0)
#define PG8_MMA(ai, bj, At, Bt) do { __builtin_amdgcn_s_setprio(1); _Pragma("unroll") for (int m = 0; m < 4; ++m) _Pragma("unroll") for (int n = 0; n < 2; ++n) _Pragma("unroll") for (int k = 0; k < 2; ++k) \
        acc[ai][bj][m][n] = __builtin_amdgcn_mfma_f32_16x16x32_bf16(Bt[n][k], At[m][k], acc[ai][bj][m][n], 0, 0, 0); __builtin_amdgcn_s_setprio(0); } while (0)
#define PG8_WAIT_V(n) asm volatile("s_waitcnt vmcnt(" #n ")" ::: "memory")
#define PG8_WAIT_L(n) asm volatile("s_waitcnt lgkmcnt(" #n ")" ::: "memory")
#define PG8_BAR __builtin_amdgcn_s_barrier()
#define PG8_SCHED __builtin_amdgcn_sched_barrier(0)
    Unit cur, nxt; int ui = 0;
    if (!S.next(0, cur)) return;
    f32x4 acc[2][2][4][2];
#pragma unroll
    for (int a = 0; a < 2; ++a)
#pragma unroll
        for (int b = 0; b < 2; ++b)
#pragma unroll
            for (int m = 0; m < 4; ++m)
#pragma unroll
                for (int n = 0; n < 2; ++n) acc[a][b][m][n] = (f32x4){0.f, 0.f, 0.f, 0.f};
    bf16x8 At[4][2], B0[2][2], B1[2][2];
    const char* cA = (const char*)g.A + (size_t)cur.pm * tstep; const char* cB = (const char*)g.Bt + (size_t)cur.pn * tstep;
    S.a_ready(cur);
    if constexpr (SP2) {
        PG8_STAGE(PG8_SB(0, 0), cB, voffB); PG8_STAGE(PG8_SB(0, 1), cB + hstep, voffB); PG8_STAGE(PG8_SA(0, 0), cA, voffA); PG8_STAGE(PG8_SA(0, 1), cA + hstep, voffA);
        if (wr == 1) PG8_BAR;
        PG8_WAIT_V(2); PG8_BAR;
        PG8_STAGE(PG8_SB(1, 0), cB + kstep, voffB); PG8_STAGE(PG8_SA(1, 0), cA + kstep, voffA); PG8_STAGE(PG8_SB(1, 1), cB + hstep + kstep, voffB);
        PG8_WAIT_V(6); PG8_BAR;
    } else {
        PG8_STAGE(PG8_SB(0, 0), cB, voffB); PG8_STAGE(PG8_SA(0, 0), cA, voffA); PG8_STAGE(PG8_SB(0, 1), cB + hstep, voffB); PG8_STAGE(PG8_SA(0, 1), cA + hstep, voffA);
        if (wr == 1) PG8_BAR;
        PG8_WAIT_V(4); PG8_BAR;
        PG8_STAGE(PG8_SB(1, 0), cB + kstep, voffB); PG8_STAGE(PG8_SA(1, 0), cA + kstep, voffA); PG8_STAGE(PG8_SB(1, 1), cB + hstep + kstep, voffB);
        PG8_WAIT_V(6); PG8_BAR;
    }
    for (;;) {
        const bool has_next = S.next(ui + 1, nxt);
        const char* nA = has_next ? (const char*)g.A + (size_t)nxt.pm * tstep : cA; const char* nB = has_next ? (const char*)g.Bt + (size_t)nxt.pn * tstep : cB;
        for (int t = 0; t < nt; t += 2) {
            const bool last = (t == nt - 2);
            if constexpr (Epi::RS_LDS) { if (t == nt - 4) E.stage_rs(cur, tid, wid); }
            if constexpr (Epi::PREFETCH) { if (t >= nt - 8) E.prefetch(cur, lds, tid, wid, (t - (nt - 8)) >> 1); }
            const char* a1 = cA + (size_t)(t + 1) * kstep;
            const char* a2 = last ? nA : cA + (size_t)(t + 2) * kstep; const char* b2 = last ? nB : cB + (size_t)(t + 2) * kstep;
            const char* a3 = a2 + kstep; const char* b3 = b2 + kstep;
            if (last && has_next) S.a_ready(nxt);
            if constexpr (SP2) {
            PG8_LDB(B0, 0, 0); PG8_LDB(B1, 0, 1); PG8_SCHED; PG8_LDA(At, 0, 0); PG8_STAGE(PG8_SA(1, 1), a1 + hstep, voffA);
            PG8_WAIT_V(8); PG8_WAIT_L(0); PG8_BAR; PG8_MMA(0, 0, At, B0); PG8_MMA(0, 1, At, B1); PG8_BAR; PG8_SCHED;
            PG8_LDA(At, 0, 1); PG8_STAGE(PG8_SB(0, 0), b2, voffB); PG8_STAGE(PG8_SB(0, 1), b2 + hstep, voffB); PG8_STAGE(PG8_SA(0, 0), a2, voffA);
            PG8_WAIT_V(8); PG8_WAIT_L(0); PG8_BAR; PG8_MMA(1, 0, At, B0); PG8_MMA(1, 1, At, B1); PG8_BAR; PG8_SCHED;
            PG8_LDB(B0, 1, 0); PG8_LDB(B1, 1, 1); PG8_SCHED; PG8_LDA(At, 1, 0); PG8_STAGE(PG8_SA(0, 1), a2 + hstep, voffA);
            PG8_WAIT_V(8); PG8_WAIT_L(0); PG8_BAR; PG8_MMA(0, 0, At, B0); PG8_MMA(0, 1, At, B1); PG8_BAR; PG8_SCHED;
            PG8_LDA(At, 1, 1); PG8_STAGE(PG8_SB(1, 0), b3, voffB); PG8_STAGE(PG8_SB(1, 1), b3 + hstep, voffB); PG8_STAGE(PG8_SA(1, 0), a3, voffA);
            PG8_WAIT_V(8); PG8_WAIT_L(0); PG8_BAR; PG8_MMA(1, 0, At, B0); PG8_MMA(1, 1, At, B1); PG8_BAR; PG8_SCHED;
            } else {
            PG8_LDB(B0, 0, 0); PG8_SCHED; PG8_LDA(At, 0, 0); PG8_STAGE(PG8_SA(1, 1), a1 + hstep, voffA);
            PG8_WAIT_L(8); PG8_BAR; PG8_WAIT_L(0); PG8_MMA(0, 0, At, B0); PG8_BAR; PG8_SCHED;
            PG8_LDB(B1, 0, 1); PG8_STAGE(PG8_SB(0, 0), b2, voffB);
            PG8_BAR; PG8_WAIT_L(0); PG8_MMA(0, 1, At, B1); PG8_BAR;
            PG8_LDA(At, 0, 1); PG8_STAGE(PG8_SA(0, 0), a2, voffA);
            PG8_BAR; PG8_WAIT_L(0); PG8_MMA(1, 0, At, B0); PG8_BAR; PG8_SCHED;
            PG8_STAGE(PG8_SB(0, 1), b2 + hstep, voffB);
            PG8_WAIT_V(6); PG8_BAR; PG8_MMA(1, 1, At, B1); PG8_BAR;
            PG8_LDB(B0, 1, 0); PG8_SCHED; PG8_LDA(At, 1, 0); PG8_STAGE(PG8_SA(0, 1), a2 + hstep, voffA);
            PG8_WAIT_L(8); PG8_BAR; PG8_WAIT_L(0); PG8_MMA(0, 0, At, B0); PG8_BAR; PG8_SCHED;
            PG8_LDB(B1, 1, 1); PG8_STAGE(PG8_SB(1, 0), b3, voffB);
            PG8_BAR; PG8_WAIT_L(0); PG8_MMA(0, 1, At, B1); PG8_BAR;
            PG8_LDA(At, 1, 1); PG8_STAGE(PG8_SA(1, 0), a3, voffA);
            PG8_BAR; PG8_WAIT_L(0); PG8_MMA(1, 0, At, B0); PG8_BAR; PG8_SCHED;
            PG8_STAGE(PG8_SB(1, 1), b3 + hstep, voffB);
            PG8_WAIT_V(6); PG8_BAR; PG8_MMA(1, 1, At, B1); PG8_BAR;
            }
        }
        if constexpr (ALIGN_EPI) { if (wr == 0) PG8_BAR; }
        if constexpr (!Epi::AFTER_DRAIN) { E(acc, cur, wr, wc, fr, fq);
#ifdef EPI_TWICE
            if constexpr (Epi::IDEMPOTENT) { asm volatile("" ::: "memory"); E(acc, cur, wr, wc, fr, fq); }
#endif
            S.done(cur); }
        if (!has_next) break;
#pragma unroll
        for (int a = 0; a < 2; ++a)
#pragma unroll
            for (int b = 0; b < 2; ++b)
#pragma unroll
                for (int m = 0; m < 4; ++m)
#pragma unroll
                    for (int n = 0; n < 2; ++n) acc[a][b][m][n] = (f32x4){0.f, 0.f, 0.f, 0.f};
        cur = nxt; cA = nA; cB = nB; ++ui;
        if constexpr (ALIGN_EPI) { if (wr == 1) PG8_BAR; }
    }
    PG8_WAIT_V(0);
    if constexpr (!ALIGN_EPI) { if (wr == 0) PG8_BAR; }
    PG8_BAR;
    if constexpr (Epi::AFTER_DRAIN) { E.fused(acc, cur, wr, wc, fr, fq, lds, wid, lane); S.done(cur); }
#undef PG8_SA
#undef PG8_SB
#undef PG8_STAGE
#undef PG8_LDA
#undef PG8_LDB
#undef PG8_MMA
#undef PG8_WAIT_V
#undef PG8_WAIT_L
#undef PG8_BAR
#undef PG8_SCHED
}
}
#define LAS __attribute__((address_space(3)))
namespace att {
using pg8::bf16_t;
typedef short bf16x8 __attribute__((ext_vector_type(8)));
typedef short s16x4 __attribute__((ext_vector_type(4)));
typedef float f32x16 __attribute__((ext_vector_type(16)));
typedef float f32x4 __attribute__((ext_vector_type(4)));
typedef unsigned u32x4 __attribute__((ext_vector_type(4)));
typedef float f32x2_t __attribute__((ext_vector_type(2))); typedef __bf16 bf16x2_t __attribute__((ext_vector_type(2)));
typedef short v4i16_t __attribute__((ext_vector_type(4)));
constexpr int K_OFF = 0, V_OFF = 16384, FS_OFF = 32768, EXT_OFF = 33280, PFX_OFF = 35840, MISC_OFF = 35904, WSF_OFF = 36864, STG_OFF = 40960, STG_PITCH = 68;
constexpr int ATT_LDS_END = STG_OFF + 8 * 32 * STG_PITCH * 4;
static_assert(ATT_LDS_END <= 131072, "attention LDS map");

__device__ __forceinline__ unsigned cvtpk(float lo, float hi) { f32x2_t v = {lo, hi}; bf16x2_t b = __builtin_convertvector(v, bf16x2_t); return __builtin_bit_cast(unsigned, b); }
__device__ __forceinline__ void lohi(float v, float& lo, float& hi_) {
    auto rr = __builtin_amdgcn_permlane32_swap(__float_as_uint(v), __float_as_uint(v), false, false);
    lo = __uint_as_float(rr[0]); hi_ = __uint_as_float(rr[1]);
}
__device__ __forceinline__ float pair_sum(float v) { float a, b; lohi(v, a, b); return a + b; }
__device__ __forceinline__ float pair_max(float v) { float a, b; lohi(v, a, b); return fmaxf(a, b); }
__device__ __forceinline__ s16x4 vtr(const LAS unsigned char* p) { return __builtin_bit_cast(s16x4, __builtin_amdgcn_ds_read_tr16_b64_v4i16((LAS v4i16_t*)p)); }

#define PRIO_BASE(young) do { if (young) __builtin_amdgcn_s_setprio(1); else __builtin_amdgcn_s_setprio(0); } while (0)
__device__ __forceinline__ void pv(f32x16 (&o)[2], const LAS unsigned char* vp, const f32x16& p0, const f32x16& p1, const bool young) {
    u32x4 pw[4];
    pw[0] = (u32x4){cvtpk(p0[0], p0[1]), cvtpk(p0[2], p0[3]), cvtpk(p0[4], p0[5]), cvtpk(p0[6], p0[7])};
    pw[1] = (u32x4){cvtpk(p0[8], p0[9]), cvtpk(p0[10], p0[11]), cvtpk(p0[12], p0[13]), cvtpk(p0[14], p0[15])};
    pw[2] = (u32x4){cvtpk(p1[0], p1[1]), cvtpk(p1[2], p1[3]), cvtpk(p1[4], p1[5]), cvtpk(p1[6], p1[7])};
    pw[3] = (u32x4){cvtpk(p1[8], p1[9]), cvtpk(p1[10], p1[11]), cvtpk(p1[12], p1[13]), cvtpk(p1[14], p1[15])};
    __builtin_amdgcn_s_setprio(2);
#pragma unroll
    for (int dh = 0; dh < 2; ++dh)
#pragma unroll
        for (int ks = 0; ks < 4; ++ks) {
            const s16x4 lo = vtr(vp + dh * 4096 + ks * 1024), hi_ = vtr(vp + dh * 4096 + ks * 1024 + 512);
            const bf16x8 vf = __builtin_shufflevector(lo, hi_, 0, 1, 2, 3, 4, 5, 6, 7);
            o[dh] = __builtin_amdgcn_mfma_f32_32x32x16_bf16(__builtin_bit_cast(bf16x8, pw[ks]), vf, o[dh], 0, 0, 0);
        }
    PRIO_BASE(young);
}
__device__ __forceinline__ void softmax_pv(f32x16& p0, f32x16& p1, float& m, float& l, f32x16 (&o)[2], LAS float* wsf, const LAS unsigned char* vp, int r32, int hi, const bool young) {
    float rm = fmaxf(p0[0], p1[0]);
#pragma unroll
    for (int r = 1; r < 16; ++r) rm = fmaxf(rm, fmaxf(p0[r], p1[r]));
    rm = pair_max(rm);
    if (__all(rm - m < -151.0f)) return;
    const float mnew = fmaxf(m, rm), alpha = __builtin_amdgcn_exp2f(m - mnew);
    m = mnew;
    float s = 0.f;
#pragma unroll
    for (int r = 0; r < 16; ++r) { p0[r] = __builtin_amdgcn_exp2f(p0[r] - mnew); p1[r] = __builtin_amdgcn_exp2f(p1[r] - mnew); s += p0[r] + p1[r]; }
    l = l * alpha + s;
    if (__any(alpha != 1.0f)) {
        if (hi == 0) wsf[r32] = alpha;
#pragma unroll
        for (int r = 0; r < 16; ++r) { const float f = wsf[(r & 3) + 8 * (r >> 2) + 4 * hi]; o[0][r] *= f; o[1][r] *= f; }
    }
    pv(o, vp, p0, p1, young);
}
__device__ __forceinline__ void o_rows(const f32x16 (&o)[2], LAS float* stg, int r32, int hi, f32x4 (&x)[8]) {
#pragma unroll
    for (int r = 0; r < 16; ++r) { const int q = (r & 3) + 8 * (r >> 2) + 4 * hi; stg[q * STG_PITCH + r32] = o[0][r]; stg[q * STG_PITCH + 32 + r32] = o[1][r]; }
#pragma unroll
    for (int i = 0; i < 8; ++i) x[i] = *(const LAS f32x4*)(stg + r32 * STG_PITCH + 32 * hi + 4 * i);
}
__device__ __forceinline__ void store_row(bf16_t* op, const f32x4 (&x)[8]) {
#pragma unroll
    for (int i = 0; i < 4; ++i) {
        u32x4 w; w.x = cvtpk(x[2 * i][0], x[2 * i][1]); w.y = cvtpk(x[2 * i][2], x[2 * i][3]); w.z = cvtpk(x[2 * i + 1][0], x[2 * i + 1][1]); w.w = cvtpk(x[2 * i + 1][2], x[2 * i + 1][3]);
        *(u32x4*)(op + 8 * i) = w;
    }
}

template <bool MASK>
__device__ __forceinline__ void sb_weights(f32x16& p0, f32x16& p1, float tlf, int hi, float& R) {
    float Tm[8];
#pragma unroll
    for (int hf = 0; hf < 2; ++hf)
#pragma unroll
        for (int a = 0; a < 4; ++a) {
            float om[4], be[4];
#pragma unroll
            for (int j = 0; j < 4; ++j) {
                const float z = hf ? p1[4 * a + j] : p0[4 * a + j];
                const float o_ = __builtin_amdgcn_rcpf(1.0f + __builtin_amdgcn_exp2f(z));
                if (MASK) { const float vf_ = __builtin_amdgcn_fmed3f(tlf - (float)(32 * hf + 8 * a + j), 0.f, 1.f), dl = o_ - 1.0f; om[j] = __builtin_fmaf(vf_, dl, 1.0f); be[j] = -vf_ * dl; }
                else { om[j] = o_; be[j] = 1.0f - o_; }
            }
            const float s2 = om[3], s1 = om[3] * om[2], s0 = s1 * om[1];
            Tm[4 * hf + a] = s0 * om[0];
            if (hf) { p1[4 * a + 3] = be[3]; p1[4 * a + 2] = be[2] * s2; p1[4 * a + 1] = be[1] * s1; p1[4 * a] = be[0] * s0; }
            else    { p0[4 * a + 3] = be[3]; p0[4 * a + 2] = be[2] * s2; p0[4 * a + 1] = be[1] * s1; p0[4 * a] = be[0] * s0; }
        }
    float U[8], Th[8], PS[8];
#pragma unroll
    for (int k = 0; k < 8; ++k) { float lo_; lohi(Tm[k], lo_, Th[k]); U[k] = lo_ * Th[k]; }
    PS[7] = 1.0f;
#pragma unroll
    for (int k = 6; k >= 0; --k) PS[k] = PS[k + 1] * U[k + 1];
#pragma unroll
    for (int k = 0; k < 8; ++k) {
        const float Bk = PS[k] * (hi ? 1.0f : Th[k]) * R;
#pragma unroll
        for (int j = 0; j < 4; ++j) { if (k < 4) p0[4 * k + j] *= Bk; else p1[4 * (k - 4) + j] *= Bk; }
    }
    R *= PS[0] * U[0];
}

struct AttnArgs { const bf16_t* QKV; bf16_t* MIX; const float* LFC; const float* CT; const float* EXT; const float* KM; float lam, one_minus_li; };

template <int VAR>
__device__ __forceinline__ void attn_unit(LAS unsigned char* lds, const AttnArgs& A, int b, int h, int qb, const int tid) {
    const int lane = tid & 63, r32 = lane & 31, hi = lane >> 5;
    const int wid = __builtin_amdgcn_readfirstlane(tid >> 6);
    const bool young = wid >= 4;
    const int q0 = qb * 256, qw0 = q0 + 32 * wid, t = qw0 + r32, Lw = qw0 >> 6;
    const size_t rowbase = (size_t)b * SEQ;
    const bf16_t* Qp = A.QKV + rowbase * NIN + 768 * VAR + 64 * h;
    const bf16_t* Kp = Qp + 256; const bf16_t* Vp = Qp + 512;
    LAS float* FS = (LAS float*)(lds + FS_OFF);
    LAS float* EXTL = (LAS float*)(lds + EXT_OFF);
    LAS float* PFX = (LAS float*)(lds + PFX_OFF);
    LAS float* wsf = (LAS float*)(lds + WSF_OFF) + wid * 64;
    LAS float* stg = (LAS float*)(lds + STG_OFF) + wid * (32 * STG_PITCH);

    int first, n, step;
    if (VAR == 1) { const int lo_ = (4 * qb - 8) > 0 ? (4 * qb - 8) : 0; first = 4 * qb + 3; n = 4 * qb + 4 - lo_; step = -1; }
    else { first = 4 * qb + 3; n = 4 * qb + 4; step = -1; }

    if (VAR == 0) {
        if (tid < 8) { float s = 0.f; for (int c = 0; c < tid; ++c) s += A.CT[(b * 8 + c) * 4 + h]; PFX[tid] = s; }
        __syncthreads();
    }
    if (VAR == 1) { for (int i = tid; i < 640; i += 512) EXTL[i] = A.EXT[h * 640 + i]; }

    bf16x8 qr[4];
#pragma unroll
    for (int d0 = 0; d0 < 4; ++d0) qr[d0] = *(const bf16x8*)(Qp + (size_t)t * NIN + d0 * 16 + hi * 8);
    const bf16_t* ksrc = Kp + (size_t)lane * NIN + wid * 8;
    const bf16_t* vsrc = Vp + (size_t)(16 * (wid & 3) + (lane >> 2)) * NIN + (wid >> 2) * 32 + (lane & 3) * 8;
    const float* fsrc = A.LFC + (rowbase + (size_t)(tid & 63)) * 4 + h;
    u32x4 kreg, vreg; float freg = 0.f;
#define ATT_LOAD(i) do { const int kt_ = first + (i) * step; kreg = *(const u32x4*)(ksrc + (size_t)kt_ * 64 * NIN); vreg = *(const u32x4*)(vsrc + (size_t)kt_ * 64 * NIN); \
        if (VAR == 0 && tid < 64) freg = fsrc[(size_t)kt_ * 256] + PFX[kt_ >> 2]; } while (0)
#define ATT_STORE(bf) do { *(LAS u32x4*)(lds + K_OFF + (bf) * 8192 + wid * 1024 + lane * 16) = kreg; *(LAS u32x4*)(lds + V_OFF + (bf) * 8192 + wid * 1024 + lane * 16) = vreg; \
        if (VAR == 0 && tid < 64) FS[(bf) * 64 + tid] = freg; } while (0)

    float m1 = -1e30f, l1 = 0.f, m2 = -1e30f, l2 = 0.f, R = 1.f;
    bool wdone = false;
    LAS unsigned* DONE = (LAS unsigned*)(lds + MISC_OFF + 64);
    f32x16 o[2], o2[2];
#pragma unroll
    for (int r = 0; r < 16; ++r) { o[0][r] = 0.f; o[1][r] = 0.f; o2[0][r] = 0.f; o2[1][r] = 0.f; }
    float Ft = 0.f;
    if (VAR == 0) Ft = A.LFC[(rowbase + t) * 4 + h] + PFX[qb];
    const float slope2 = (VAR == 2) ? __builtin_amdgcn_exp2f(-2.0f * (float)(h + 1)) * LOG2E : 0.f;
    float qkb1 = 0.f, qkb2 = 0.f;
    if (VAR == 0 || VAR == 2) {
        float s1 = 0.f, s2 = 0.f;
#pragma unroll
        for (int d0 = 0; d0 < 4; ++d0)
#pragma unroll
            for (int j = 0; j < 4; ++j) {
                const unsigned w = __builtin_bit_cast(u32x4, qr[d0])[j];
                const float a0 = __uint_as_float(w << 16), a1 = __uint_as_float(w & 0xffff0000u);
                if (d0 < 2) s1 += a0 * a0 + a1 * a1; else s2 += a0 * a0 + a1 * a1;
            }
        const float* km = A.KM + (((VAR == 2 ? 32 : 0) + b) * 4 + h) * 2;
        if (VAR == 0) qkb1 = sqrtf(pair_sum(s1 + s2)) * sqrtf(km[0] + km[1]) * 1.01f;
        else { qkb1 = sqrtf(pair_sum(s1)) * sqrtf(km[0]) * 1.01f; qkb2 = sqrtf(pair_sum(s2)) * sqrtf(km[1]) * 1.01f; }
    }

    ATT_LOAD(0); ATT_STORE(0);
    if (n > 1) ATT_LOAD(1);
    __syncthreads();
    for (int i = 0; i < n; ++i) {
        const int kt = first + i * step, buf = i & 1;
        const bool part = (VAR == 1) ? (kt <= Lw && kt >= Lw - 8) : (kt <= Lw);
        if (part && !wdone) {
            const LAS unsigned char* kb = lds + K_OFF + buf * 8192 + hi * 1024 + r32 * 16;
            const LAS unsigned char* vp = lds + V_OFF + buf * 8192 + ((lane >> 4) & 1) * 32 + (lane & 3) * 8 + (4 * hi + ((lane & 15) >> 2)) * 64;
            const bool diag = (kt == Lw);
            const int tl = t - 64 * kt - 4 * hi;
            if (VAR == 2) {
                const float tb = (float)tl;
#pragma unroll
                for (int mp = 0; mp < 2; ++mp) {
                    f32x16 p0, p1;
#pragma unroll
                    for (int r = 0; r < 16; ++r) { p0[r] = 0.f; p1[r] = 0.f; }
                    __builtin_amdgcn_s_setprio(2);
#pragma unroll
                    for (int dd = 0; dd < 2; ++dd) {
                        const int d0 = 2 * mp + dd;
                        const bf16x8 b0 = *(const LAS bf16x8*)(kb + d0 * 2048), b1 = *(const LAS bf16x8*)(kb + d0 * 2048 + 512);
                        p0 = __builtin_amdgcn_mfma_f32_32x32x16_bf16(b0, qr[d0], p0, 0, 0, 0);
                        p1 = __builtin_amdgcn_mfma_f32_32x32x16_bf16(b1, qr[d0], p1, 0, 0, 0);
                    }
                    PRIO_BASE(young);
#pragma unroll
                    for (int r = 0; r < 16; ++r) {
                        const float c0 = (float)((r & 3) + 8 * (r >> 2));
                        p0[r] = __builtin_fmaf(-slope2, __builtin_fabsf(tb - c0), p0[r]);
                        p1[r] = __builtin_fmaf(-slope2, __builtin_fabsf(tb - (c0 + 32.0f)), p1[r]);
                    }
                    if (mp == 0) softmax_pv(p0, p1, m1, l1, o, wsf, vp, r32, hi, young);
                    else softmax_pv(p0, p1, m2, l2, o2, wsf, vp, r32, hi, young);
                    __builtin_amdgcn_sched_barrier(0);
                }
                { const float bf = -slope2 * (float)(tl + 4 * hi + 1);
                  wdone = __all((qkb1 + bf - m1 < -151.0f) && (qkb2 + bf - m2 < -151.0f)); }
            } else {
                f32x16 p0, p1;
#pragma unroll
                for (int r = 0; r < 16; ++r) { p0[r] = 0.f; p1[r] = 0.f; }
                __builtin_amdgcn_s_setprio(2);
#pragma unroll
                for (int d0 = 0; d0 < 4; ++d0) {
                    const bf16x8 b0 = *(const LAS bf16x8*)(kb + d0 * 2048), b1 = *(const LAS bf16x8*)(kb + d0 * 2048 + 512);
                    p0 = __builtin_amdgcn_mfma_f32_32x32x16_bf16(b0, qr[d0], p0, 0, 0, 0);
                    p1 = __builtin_amdgcn_mfma_f32_32x32x16_bf16(b1, qr[d0], p1, 0, 0, 0);
                }
                PRIO_BASE(young);
                if (VAR == 0) {
                    const LAS float* fs = FS + buf * 64 + 4 * hi;
#pragma unroll
                    for (int a = 0; a < 4; ++a) {
                        const f32x4 f0 = *(const LAS f32x4*)(fs + 8 * a), f1 = *(const LAS f32x4*)(fs + 32 + 8 * a);
#pragma unroll
                        for (int j = 0; j < 4; ++j) { p0[4 * a + j] += Ft - f0[j]; p1[4 * a + j] += Ft - f1[j]; }
                    }
                    if (diag) {
                        const float tlf = (float)tl;
#pragma unroll
                        for (int r = 0; r < 16; ++r) { const float c0 = (float)((r & 3) + 8 * (r >> 2));
                            p0[r] = __builtin_fmaf(fminf(tlf - c0, 0.f), 1e30f, p0[r]); p1[r] = __builtin_fmaf(fminf(tlf - (c0 + 32.0f), 0.f), 1e30f, p1[r]); }
                    }
                    softmax_pv(p0, p1, m1, l1, o, wsf, vp, r32, hi, young);
                    wdone = __all(qkb1 + (Ft - FS[buf * 64]) - m1 < -151.0f);
                } else if (VAR == 1) {
                    const LAS float* eb = EXTL + (576 - tl);
#pragma unroll
                    for (int r = 0; r < 16; ++r) { const int c0 = (r & 3) + 8 * (r >> 2); p0[r] += eb[c0]; p1[r] += eb[c0 + 32]; }
                    softmax_pv(p0, p1, m1, l1, o, wsf, vp, r32, hi, young);
                } else {
                    if (diag) sb_weights<true>(p0, p1, (float)tl, hi, R); else sb_weights<false>(p0, p1, 0.f, hi, R);
                    pv(o, vp, p0, p1, young);
                    wdone = __all(R == 0.f);
                }
            }
        }
        if (i + 1 < n) ATT_STORE((i + 1) & 1);
        if (i + 2 < n) ATT_LOAD(i + 2);
        if (VAR != 1 && lane == 0) DONE[(i & 1) * 8 + wid] = wdone ? 1u : 0u;
        __syncthreads();
        if (VAR != 1) {
            const u32x4 d0 = *(const LAS u32x4*)(DONE + (i & 1) * 8), d1 = *(const LAS u32x4*)(DONE + (i & 1) * 8 + 4);
            if ((d0[0] & d0[1] & d0[2] & d0[3] & d1[0] & d1[1] & d1[2] & d1[3]) != 0u) break;
        }
    }
#undef ATT_LOAD
#undef ATT_STORE
    bf16_t* op = A.MIX + (rowbase + t) * DM + 256 * VAR + 64 * h + 32 * hi;
    f32x4 x[8];
    if (VAR == 0 || VAR == 1) {
        const float inv = 1.0f / pair_sum(l1);
        o_rows(o, stg, r32, hi, x);
#pragma unroll
        for (int i = 0; i < 8; ++i) x[i] = x[i] * inv;
        store_row(op, x);
    } else if (VAR == 3) {
        o_rows(o, stg, r32, hi, x);
        store_row(op, x);
    } else {
        const float inv1 = 1.0f / pair_sum(l1), inv2 = A.lam / pair_sum(l2);
        f32x4 y[8];
        o_rows(o, stg, r32, hi, x);
        o_rows(o2, stg, r32, hi, y);
        float ss = 0.f;
#pragma unroll
        for (int i = 0; i < 8; ++i) { x[i] = x[i] * inv1 - y[i] * inv2; ss += (x[i][0] * x[i][0] + x[i][1] * x[i][1]) + (x[i][2] * x[i][2] + x[i][3] * x[i][3]); }
        ss = pair_sum(ss);
        const float sc = __builtin_amdgcn_rsqf(ss * (1.0f / 64.0f) + RMS_EPS) * A.one_minus_li;
#pragma unroll
        for (int i = 0; i < 8; ++i) x[i] = x[i] * sc;
        store_row(op, x);
    }
}

__device__ __forceinline__ void attn_phase(LAS unsigned char* lds, const AttnArgs& A, unsigned* ctr, const int tid) {
    volatile LAS unsigned* MISC = (volatile LAS unsigned*)(lds + MISC_OFF);
    if (__builtin_amdgcn_readfirstlane(tid) >= 256) __builtin_amdgcn_s_setprio(1);
    if (tid == 0) MISC[0] = atomicAdd(ctr, 1u);
    __syncthreads();
    unsigned u = MISC[0];
    for (int it = 0; u < 4096u; ++it) {
        if (tid == 0) MISC[1 + (it & 1)] = atomicAdd(ctr, 1u);
        int var, qb, bh;
        if (u < 3072u) { qb = 7 - (int)(u / 384u); const int rem = (int)(u % 384u); const int vi = rem >> 7; var = (vi == 0) ? 3 : (vi == 1) ? 2 : 0; bh = rem & 127; }
        else { const int v = (int)u - 3072; var = 1; qb = 7 - (v >> 7); bh = v & 127; }
        const int b = bh >> 2, h = bh & 3;
        int tid_u = tid; asm volatile("" : "+v"(tid_u));
        if (var == 0) attn_unit<0>(lds, A, b, h, qb, tid_u);
        else if (var == 1) attn_unit<1>(lds, A, b, h, qb, tid_u);
        else if (var == 2) attn_unit<2>(lds, A, b, h, qb, tid_u);
        else attn_unit<3>(lds, A, b, h, qb, tid_u);
        u = MISC[1 + (it & 1)];
    }
    __builtin_amdgcn_s_setprio(0);
}
}
using pg8::bf16_t;
typedef float f32x4g __attribute__((ext_vector_type(4)));
typedef unsigned v4u __attribute__((ext_vector_type(4)));
constexpr size_t MiB = 1u << 20;
constexpr size_t WS_CTL = 0, WS_WF = 1 * MiB, WS_LAM = 1 * MiB + 65536, WS_EXT = 1 * MiB + 131072, WS_KM = 1 * MiB + 262144;
constexpr size_t WS_W = 16 * MiB, W_LAYER = 44 * MiB, W_GU1 = 0, W_D1 = 11 * MiB, W_GU2 = 33 * MiB / 2, W_D2 = 55 * MiB / 2, W_IN = 33 * MiB, W_O = 39 * MiB;
constexpr size_t WS_XB = 128 * MiB, WS_SS = 256 * MiB, WS_LFC = 260 * MiB, WS_CT = 261 * MiB, WS_BIG = 272 * MiB, WS_MIX = 656 * MiB, WS_END = 784 * MiB;
constexpr int LDS_BYTES = 163840;
constexpr int LDS_RS = 133120;
constexpr int NWAVES = 8;
#ifndef REP_ATT
#define REP_ATT 1
#endif
#ifndef REP_RES
#define REP_RES 1
#endif
#ifndef REP_IN
#define REP_IN 1
#endif
#ifndef REP_PRO
#define REP_PRO 1
#endif
#ifndef REP_THIN
#define REP_THIN 1
#endif
#ifndef ALIGN_RES
#define ALIGN_RES true
#endif
#ifndef GEMM_SP2
#define GEMM_SP2 true
#endif
#ifndef REP_GU
#define REP_GU 1
#endif

__device__ __forceinline__ unsigned f2bf(float f) { unsigned u = __builtin_bit_cast(unsigned, f); return (u + 0x7fffu + ((u >> 16) & 1u)) >> 16; }
__device__ __forceinline__ unsigned pk2(float lo, float hi) { return f2bf(lo) | (f2bf(hi) << 16); }
__device__ __forceinline__ float wave_sum(float v) {
#pragma unroll
    for (int o = 1; o < 64; o <<= 1) v += __shfl_xor(v, o);
    return v;
}
__device__ __forceinline__ void transpose_item(const float* W, int K, int Nsrc, bf16_t* WT, const float* g, int n0, int c0, int k0, LAS float* scr, int lane) {
    float tv[32];
#pragma unroll
    for (int i = 0; i < 32; ++i) { const int kk = 2 * i + (lane >> 5); tv[i] = __builtin_nontemporal_load(W + (size_t)(k0 + kk) * Nsrc + c0 + (lane & 31)); }
    const float gl = g ? g[k0 + lane] : 1.0f;
#pragma unroll
    for (int i = 0; i < 32; ++i) { const int kk = 2 * i + (lane >> 5); scr[kk * 33 + (lane & 31)] = tv[i] * __shfl(gl, kk); }
    asm volatile("s_waitcnt lgkmcnt(0)" ::: "memory");
    const int c = lane & 7;
#pragma unroll
    for (int j = 0; j < 4; ++j) { const int nn = (lane >> 3) + 8 * j; const LAS float* s = scr + (8 * c) * 33 + nn;
        v4u o; o.x = pk2(s[0 * 33], s[1 * 33]); o.y = pk2(s[2 * 33], s[3 * 33]); o.z = pk2(s[4 * 33], s[5 * 33]); o.w = pk2(s[6 * 33], s[7 * 33]);
        *(v4u*)(WT + (size_t)(n0 + nn) * K + k0 + 8 * c) = o; }
    asm volatile("s_waitcnt lgkmcnt(0)" ::: "memory");
}
__device__ __forceinline__ int map_col(int mode, int n) {
    if (mode == 1) { const int tt = n >> 8, w = n & 255; return (w < 128) ? 128 * tt + w : DFF + 128 * tt + (w - 128); }
    if (mode == 2) return n < 768 ? n : n + 4;
    return n;
}
__device__ __forceinline__ void transpose_matrix(const float* W, int K, int Nsrc, int Ndst, bf16_t* WT, const float* g, int mode, int item, LAS float* scr, int lane) {
    const int nblk = Ndst / 32, kb = item / nblk, nb = item % nblk;
    transpose_item(W, K, Nsrc, WT, g, 32 * nb, map_col(mode, 32 * nb), 64 * kb, scr, lane);
}

#define XB_TMO      128
#define XB_XCNT(j)  (256  + 64 * (j))
#define XB_XSUB(j)  (1280 + 64 * (j))
#define XB_XGEN(j)  (2304 + 64 * (j))
#define XB_TOP      3328
#define XB_TOPGEN   3392
#define XCD_BAR_WORDS 3456
#define XB_SPIN_CAP (1u << 18)

__device__ __forceinline__ unsigned xb_ld(unsigned* p)              { return __hip_atomic_load(p, __ATOMIC_RELAXED, __HIP_MEMORY_SCOPE_AGENT); }
__device__ __forceinline__ unsigned xb_add(unsigned* p, unsigned v) { return __hip_atomic_fetch_add(p, v, __ATOMIC_RELAXED, __HIP_MEMORY_SCOPE_AGENT); }
__device__ __forceinline__ unsigned xb_xcc_id() { return (unsigned)__builtin_amdgcn_s_getreg((3 << 11) | 20) & 0xFu; }
#define XB_SPIN(cond, bar) do { unsigned _sp = 0; while (cond) { __builtin_amdgcn_s_sleep(1); \
    if ((++_sp & 255u) == 0u) { if (xb_ld(&(bar)[XB_TMO])) break; if (_sp > XB_SPIN_CAP) { atomicAdd(&(bar)[XB_TMO], 1u); break; } } } } while (0)

struct XcdBarrier {
    unsigned* bar; unsigned x;
    volatile LAS unsigned* st;
};

__device__ __forceinline__ XcdBarrier xcd_barrier_post(unsigned* bar, volatile LAS unsigned* st) {
    XcdBarrier b; b.bar = bar; b.x = xb_xcc_id(); b.st = st;
    if (threadIdx.x == 0) (void)xb_add(&bar[XB_XCNT(b.x)], 1u);
    return b;
}
__device__ __forceinline__ void xcd_barrier_complete(unsigned* bar, unsigned x, unsigned& nloc, unsigned& nx) {
    const unsigned G = gridDim.x * gridDim.y * gridDim.z;
    unsigned sum, cnt, mine, sp = 0u;
    for (;;) {
        sum = 0u; cnt = 0u; mine = 0u;
#pragma unroll
        for (unsigned j = 0; j < 16; ++j) { const unsigned c = xb_ld(&bar[XB_XCNT(j)]); sum += c; cnt += (c > 0u) ? 1u : 0u; mine = (j == x) ? c : mine; }
        if (sum == G) break;
        __builtin_amdgcn_s_sleep(1);
        if ((++sp & 255u) == 0u) { if (xb_ld(&bar[XB_TMO])) break; if (sp > XB_SPIN_CAP) { atomicAdd(&bar[XB_TMO], 1u); break; } }
    }
    nloc = mine > 0u ? mine : 1u; nx = cnt > 0u ? cnt : 1u;
}

__device__ __forceinline__ void xcd_barrier(const XcdBarrier& b) {
    asm volatile("s_waitcnt vmcnt(0)" ::: "memory");
    __syncthreads();
    if (threadIdx.x == 0) {
        unsigned* bar = b.bar;
        __builtin_amdgcn_s_waitcnt(0);
        unsigned nloc = b.st[0], nx = b.st[1];
        if (nloc == 0u) { xcd_barrier_complete(bar, b.x, nloc, nx); b.st[0] = nloc; b.st[1] = nx; }
        const unsigned old = xb_add(&bar[XB_XSUB(b.x)], 1u);
        const unsigned gen = old / nloc;
        if (old + 1u == (gen + 1u) * nloc) {
            __builtin_amdgcn_fence(__ATOMIC_RELEASE, "agent");
            asm volatile("s_waitcnt vmcnt(0)" ::: "memory");
            const unsigned og = xb_add(&bar[XB_TOP], 1u);
            const unsigned tg = og / nx;
            if (og + 1u == (tg + 1u) * nx) xb_add(&bar[XB_TOPGEN], 1u);
            else XB_SPIN(xb_ld(&bar[XB_TOPGEN]) == tg, bar);
            __builtin_amdgcn_fence(__ATOMIC_ACQUIRE, "agent");
            xb_add(&bar[XB_XGEN(b.x)], 1u);
            asm volatile("s_waitcnt vmcnt(0)" ::: "memory");
        } else {
            XB_SPIN(xb_ld(&bar[XB_XGEN(b.x)]) == gen, bar);
            __builtin_amdgcn_fence(__ATOMIC_ACQUIRE, "agent");
            asm volatile("s_waitcnt vmcnt(0)" ::: "memory");
        }
    }
    __syncthreads();
}

constexpr int CW_BAR = 4096;
constexpr int LDS_BARST = 131072 + 64;
struct Params { const float* in[14]; float* out; unsigned char* ws; };

typedef __attribute__((address_space(4))) const Params* KP;
__device__ __forceinline__ KP kparams() {
    auto p = (const __attribute__((address_space(4))) unsigned char*)__builtin_amdgcn_kernarg_segment_ptr();
    asm volatile("" : "+s"(p)); return (KP)p;
}
#define PH_COMMON const KP kp = kparams(); unsigned char* const ws = kp->ws; int tid_ = threadIdx.x; asm volatile("" : "+v"(tid_)); const int tid = tid_, lane = tid & 63, wave = __builtin_amdgcn_readfirstlane(tid >> 6); const int G = gridDim.x; (void)ws; (void)lane; (void)wave; (void)G;

__global__ void __launch_bounds__(512, 2) fwd_kernel(Params Punused) {
    extern __shared__ __attribute__((aligned(16))) unsigned char lds_raw[];
    LAS unsigned char* lds = (LAS unsigned char*)lds_raw;
    cg::grid_group grid = cg::this_grid();
    volatile LAS unsigned* const barst = (volatile LAS unsigned*)(lds + LDS_BARST);
    if (threadIdx.x < 2) barst[threadIdx.x] = 0u;
    if (blockIdx.x == 0) { unsigned* bw = (unsigned*)(kparams()->ws + WS_CTL) + CW_BAR; for (int i = threadIdx.x; i < XCD_BAR_WORDS; i += 512) bw[i] = 0u; }
#define GRID_BAR() do { XcdBarrier b_; b_.bar = (unsigned*)(kparams()->ws + WS_CTL) + CW_BAR; b_.x = xb_xcc_id(); b_.st = barst; xcd_barrier(b_); } while (0)

    for (int rep_ = 0; rep_ < REP_PRO; ++rep_) {
        PH_COMMON
        const int gw = blockIdx.x * NWAVES + wave, NGW = G * NWAVES;
        LAS float* scr = (LAS float*)(lds + wave * 16384);
        constexpr int I_GU = (DM / 64) * (NGU / 32), I_D = (DFF / 64) * (DM / 32), I_IN = (DM / 64) * (NIN / 32), I_O = (DM / 64) * (DM / 32);
        constexpr int I_LAYER = 2 * I_GU + 2 * I_D + I_IN + I_O;
        for (int it = gw; it < 2 * I_LAYER; it += NGW) {
            const int l = it / I_LAYER; int r = it % I_LAYER;
            unsigned char* wl = ws + WS_W + (size_t)l * W_LAYER;
            if (r < I_GU) { transpose_matrix(kp->in[2] + (size_t)l * DM * NGU, DM, NGU, NGU, (bf16_t*)(wl + W_GU1), kp->in[1] + l * DM, 1, r, scr, lane); continue; } r -= I_GU;
            if (r < I_GU) { transpose_matrix(kp->in[11] + (size_t)l * DM * NGU, DM, NGU, NGU, (bf16_t*)(wl + W_GU2), kp->in[10] + l * DM, 1, r, scr, lane); continue; } r -= I_GU;
            if (r < I_D) { transpose_matrix(kp->in[3] + (size_t)l * DFF * DM, DFF, DM, DM, (bf16_t*)(wl + W_D1), nullptr, 0, r, scr, lane); continue; } r -= I_D;
            if (r < I_D) { transpose_matrix(kp->in[12] + (size_t)l * DFF * DM, DFF, DM, DM, (bf16_t*)(wl + W_D2), nullptr, 0, r, scr, lane); continue; } r -= I_D;
            if (r < I_IN) { transpose_matrix(kp->in[5] + (size_t)l * DM * INW, DM, INW, NIN, (bf16_t*)(wl + W_IN), kp->in[4] + l * DM, 2, r, scr, lane); continue; } r -= I_IN;
            transpose_matrix(kp->in[9] + (size_t)l * DM * DM, DM, DM, DM, (bf16_t*)(wl + W_O), nullptr, 0, r, scr, lane);
        }
        const float* x_in = kp->in[0]; bf16_t* XB = (bf16_t*)(ws + WS_XB); float* SS = (float*)(ws + WS_SS);
        for (int m0 = gw * 4; m0 < MROWS; m0 += NGW * 4) {
            f32x4g v[4][4]; float s[4];
#pragma unroll
            for (int q = 0; q < 4; ++q) { const f32x4g* xr = (const f32x4g*)(x_in + (size_t)(m0 + q) * DM) + lane;
#pragma unroll
                for (int j = 0; j < 4; ++j) v[q][j] = __builtin_nontemporal_load(xr + 64 * j); }
#pragma unroll
            for (int q = 0; q < 4; ++q) { s[q] = 0.f;
#pragma unroll
                for (int j = 0; j < 4; ++j) s[q] += (v[q][j][0] * v[q][j][0] + v[q][j][1] * v[q][j][1]) + (v[q][j][2] * v[q][j][2] + v[q][j][3] * v[q][j][3]);
                s[q] = wave_sum(s[q]); }
#pragma unroll
            for (int q = 0; q < 4; ++q) {
                unsigned long long* o8 = (unsigned long long*)(XB + (size_t)(m0 + q) * DM) + lane;
#pragma unroll
                for (int j = 0; j < 4; ++j) o8[64 * j] = (unsigned long long)pk2(v[q][j][0], v[q][j][1]) | ((unsigned long long)pk2(v[q][j][2], v[q][j][3]) << 32);
            }
            { const int q = lane >> 4; const float sq = q == 0 ? s[0] : q == 1 ? s[1] : q == 2 ? s[2] : s[3]; SS[(size_t)m0 * 16 + lane] = ((lane & 15) == 0) ? sq : 0.f; }
        }
        float* WF = (float*)(ws + WS_WF); float* LAM = (float*)(ws + WS_LAM); float* EXT = (float*)(ws + WS_EXT); unsigned* CTL = (unsigned*)(ws + WS_CTL);
        const int gt = blockIdx.x * 512 + tid, NGT = G * 512;
        for (int i = gt; i < 2 * 4 * DM; i += NGT) { const int l = i / (4 * DM), hh = (i / DM) & 3, k = i % DM; WF[i] = kp->in[4][l * DM + k] * kp->in[5][((size_t)l * DM + k) * INW + 768 + hh]; }
        for (int i = gt; i < 2 * 512; i += NGT) ((unsigned*)(ws + WS_KM))[i] = 0u;
        for (int i = gt; i < 2 * 4 * 640; i += NGT) { const int lh = i / 640, j = i % 640; int d = 576 - j; d = d < -256 ? -256 : (d > 256 ? 256 : d); EXT[i] = kp->in[7][lh * NREL + d + 256] * LOG2E; }
        if (blockIdx.x == 0 && tid < 2) {
            const float* lp = kp->in[8] + tid * 128; float a = 0.f, b2 = 0.f;
            for (int i = 0; i < 32; ++i) { a += lp[i] * lp[32 + i]; b2 += lp[64 + i] * lp[96 + i]; }
            const float li = 0.8f - 0.6f * expf(-0.3f * (float)tid);
            LAM[tid * 2] = expf(a) - expf(b2) + li; LAM[tid * 2 + 1] = 1.0f - li;
            CTL[64 * tid] = 0u; CTL[64 * (tid + 2)] = 0u;
        }
    }
    grid.sync();
    (void)xcd_barrier_post((unsigned*)(kparams()->ws + WS_CTL) + CW_BAR, barst);

    for (int st = 0; st < 6; ++st) {
        const int l = st / 3, k = st % 3;
        if (k != 1) {
            {
                PH_COMMON
                unsigned char* wl = ws + WS_W + (size_t)l * W_LAYER;
                pg8::Gemm g{(const bf16_t*)(ws + WS_XB), (const bf16_t*)(wl + (k == 0 ? W_GU1 : W_GU2)), MROWS, NGU, DM}; pg8::StaticOrder S; S.init(MROWS, NGU, G, (int)blockIdx.x);
                pg8::EpiGU E{(bf16_t*)(ws + WS_BIG), (const float*)(ws + WS_SS), lds + LDS_RS};
                S.rep = REP_GU; pg8::gemm_phase<pg8::EpiGU, pg8::StaticOrder, true, GEMM_SP2>(lds, g, S, E, tid);
            }
            GRID_BAR();
        } else {
            {
                PH_COMMON
                const bf16_t* XBr = (const bf16_t*)(ws + WS_XB); float* LFC = (float*)(ws + WS_LFC); float* CT = (float*)(ws + WS_CT);
                LAS float* lfs = (LAS float*)lds;
                const float* wf = (const float*)(ws + WS_WF) + l * 4 * DM;
                f32x4g w[4][4];
#pragma unroll
                for (int hh = 0; hh < 4; ++hh)
#pragma unroll
                    for (int j = 0; j < 4; ++j) w[hh][j] = *(const f32x4g*)(wf + hh * DM + 512 * (j >> 1) + 8 * lane + 4 * (j & 1));
                const float bfv = kp->in[6][l * 4 + (lane & 3)];
                for (int rep_ = 0; rep_ < REP_THIN; ++rep_)
                for (int ch = blockIdx.x; ch < MROWS / 256; ch += G) {
                    for (int rr = 0; rr < 32; rr += 4) {
                        const int rl = wave * 32 + rr; const size_t m = (size_t)ch * 256 + rl;
                        v4u xv[4][2];
#pragma unroll
                        for (int q = 0; q < 4; ++q)
#pragma unroll
                            for (int j = 0; j < 2; ++j) xv[q][j] = *(const v4u*)(XBr + (m + q) * DM + 512 * j + 8 * lane);
#pragma unroll
                        for (int q = 0; q < 4; ++q) {
                            float s = 0.f, d[4] = {0.f, 0.f, 0.f, 0.f};
#pragma unroll
                            for (int j = 0; j < 4; ++j) {
                                const unsigned u0 = xv[q][j >> 1][2 * (j & 1)], u1 = xv[q][j >> 1][2 * (j & 1) + 1];
                                const float a0 = __uint_as_float(u0 << 16), a1 = __uint_as_float(u0 & 0xffff0000u), a2 = __uint_as_float(u1 << 16), a3 = __uint_as_float(u1 & 0xffff0000u);
                                s += (a0 * a0 + a1 * a1) + (a2 * a2 + a3 * a3);
#pragma unroll
                                for (int hh = 0; hh < 4; ++hh) d[hh] += (a0 * w[hh][j][0] + a1 * w[hh][j][1]) + (a2 * w[hh][j][2] + a3 * w[hh][j][3]);
                            }
                            s = wave_sum(s);
#pragma unroll
                            for (int hh = 0; hh < 4; ++hh) d[hh] = wave_sum(d[hh]);
                            const float rs = 1.0f / sqrtf(s * (1.0f / DM) + RMS_EPS);
                            const float dsel = (lane & 3) == 0 ? d[0] : (lane & 3) == 1 ? d[1] : (lane & 3) == 2 ? d[2] : d[3];
                            const float z = dsel * rs + bfv;
                            const float lf = fminf(z, 0.f) - log1pf(expf(-fabsf(z)));
                            if (lane < 4) lfs[(rl + q) * 4 + lane] = lf * LOG2E;
                        }
                    }
                    __syncthreads();
                    if (wave < 4) {
                        const int hh = wave; float v0 = lfs[(4 * lane) * 4 + hh], v1 = lfs[(4 * lane + 1) * 4 + hh], v2 = lfs[(4 * lane + 2) * 4 + hh], v3 = lfs[(4 * lane + 3) * 4 + hh];
                        v1 += v0; v2 += v1; v3 += v2;
                        float inc = v3;
#pragma unroll
                        for (int o = 1; o < 64; o <<= 1) { const float tq = __shfl_up(inc, o); if (lane >= o) inc += tq; }
                        const float ex = inc - v3;
                        float* dst = LFC + ((size_t)ch * 256 + 4 * lane) * 4 + hh;
                        dst[0] = ex + v0; dst[4] = ex + v1; dst[8] = ex + v2; dst[12] = ex + v3;
                        if (lane == 63) CT[ch * 4 + hh] = inc;
                    }
                    __syncthreads();
                }
            }
            {
                PH_COMMON
                unsigned char* wl = ws + WS_W + (size_t)l * W_LAYER;
                pg8::Gemm g{(const bf16_t*)(ws + WS_XB), (const bf16_t*)(wl + W_IN), MROWS, NIN, DM}; pg8::StaticOrder S; S.init(MROWS, NIN, G, (int)blockIdx.x);
                pg8::EpiQKV E{(bf16_t*)(ws + WS_BIG), (const float*)(ws + WS_SS), lds + LDS_RS, (unsigned*)(ws + WS_KM) + 512 * l};
                S.rep = REP_IN; pg8::gemm_phase<pg8::EpiQKV, pg8::StaticOrder, true, GEMM_SP2>(lds, g, S, E, tid);
            }
            GRID_BAR();
            {
                PH_COMMON
                const float* LAM = (const float*)(ws + WS_LAM);
                att::AttnArgs A{(const bf16_t*)(ws + WS_BIG), (bf16_t*)(ws + WS_MIX), (const float*)(ws + WS_LFC), (const float*)(ws + WS_CT), (const float*)(ws + WS_EXT) + l * 4 * 640, (const float*)(ws + WS_KM) + 512 * l, LAM[2 * l], LAM[2 * l + 1]};
                for (int rep = 0; rep < REP_ATT; ++rep) att::attn_phase(lds, A, (unsigned*)(ws + WS_CTL) + 64 * (l + 2 * rep), tid);
            }
            GRID_BAR();
        }
        {
            PH_COMMON
            unsigned char* wl = ws + WS_W + (size_t)l * W_LAYER;
            pg8::Gemm g = (k != 1) ? pg8::Gemm{(const bf16_t*)(ws + WS_BIG), (const bf16_t*)(wl + (k == 0 ? W_D1 : W_D2)), MROWS, DM, DFF} : pg8::Gemm{(const bf16_t*)(ws + WS_MIX), (const bf16_t*)(wl + W_O), MROWS, DM, DM};
            pg8::StaticOrder S; S.init(MROWS, DM, G, (int)blockIdx.x);
            pg8::EpiRes E{(bf16_t*)(ws + WS_XB), (float*)(ws + WS_SS), (k != 1) ? 0.5f : 1.0f};
            S.rep = REP_RES; pg8::gemm_phase<pg8::EpiRes, pg8::StaticOrder, ALIGN_RES, GEMM_SP2>(lds, g, S, E, tid);
        }
        GRID_BAR();
    }
#ifdef EXTRA_SYNCS
    for (int i = 0; i < EXTRA_SYNCS; ++i) GRID_BAR();
#endif
    {
        PH_COMMON
        const int gw = blockIdx.x * NWAVES + wave, NGW = G * NWAVES;
        float* OUT = kp->out; const bf16_t* XBr = (const bf16_t*)(ws + WS_XB);
        const float* gf = kp->in[13];
        f32x4g gv[4];
#pragma unroll
        for (int j = 0; j < 4; ++j) gv[j] = *(const f32x4g*)(gf + 512 * (j >> 1) + 8 * lane + 4 * (j & 1));
        for (int rep_ = 0; rep_ < REP_THIN; ++rep_)
        for (int m0 = gw * 4; m0 < MROWS; m0 += NGW * 4) {
            v4u xv[4][2];
#pragma unroll
            for (int q = 0; q < 4; ++q)
#pragma unroll
                for (int j = 0; j < 2; ++j) xv[q][j] = __builtin_nontemporal_load((const v4u*)(XBr + (size_t)(m0 + q) * DM + 512 * j + 8 * lane));
#pragma unroll
            for (int q = 0; q < 4; ++q) {
                f32x4g v[4]; float s = 0.f;
#pragma unroll
                for (int j = 0; j < 4; ++j) {
                    const unsigned u0 = xv[q][j >> 1][2 * (j & 1)], u1 = xv[q][j >> 1][2 * (j & 1) + 1];
                    v[j] = (f32x4g){__uint_as_float(u0 << 16), __uint_as_float(u0 & 0xffff0000u), __uint_as_float(u1 << 16), __uint_as_float(u1 & 0xffff0000u)};
                    s += (v[j][0] * v[j][0] + v[j][1] * v[j][1]) + (v[j][2] * v[j][2] + v[j][3] * v[j][3]);
                }
                s = wave_sum(s);
                const float rs = 1.0f / sqrtf(s * (1.0f / DM) + RMS_EPS);
                float* orow = OUT + (size_t)(m0 + q) * DM;
#pragma unroll
                for (int j = 0; j < 4; ++j) __builtin_nontemporal_store(v[j] * rs * gv[j], (f32x4g*)(orow + 512 * (j >> 1) + 8 * lane + 4 * (j & 1)));
            }
        }
    }
}

extern "C" void kernel_launch(void* const* d_in, const int* in_sizes, int n_in, void* d_out, int out_size, void* d_ws, size_t ws_size, hipStream_t stream) {
    static int grid = 0;
    if (grid == 0) {
        if (n_in != 14 || in_sizes[0] != MROWS * DM || out_size != MROWS * DM || ws_size < WS_END) {
            fprintf(stderr, "kernel_launch: unexpected problem (n_in %d, in0 %d, out %d, ws %zu); nothing launched\n", n_in, n_in > 0 ? in_sizes[0] : -1, out_size, ws_size); grid = -1; return; }
        int dev = 0, cus = 0, per_cu = 0;
        (void)hipGetDevice(&dev);
        (void)hipDeviceGetAttribute(&cus, hipDeviceAttributeMultiprocessorCount, dev);
        if (hipFuncSetAttribute((const void*)fwd_kernel, hipFuncAttributeMaxDynamicSharedMemorySize, LDS_BYTES) != hipSuccess) fprintf(stderr, "kernel_launch: hipFuncSetAttribute failed\n");
        if (hipOccupancyMaxActiveBlocksPerMultiprocessor(&per_cu, (const void*)fwd_kernel, 512, LDS_BYTES) != hipSuccess || per_cu < 1) { fprintf(stderr, "kernel_launch: occupancy query gave %d\n", per_cu); per_cu = 1; }
        (void)hipGetLastError();
        grid = cus * per_cu;
        fprintf(stderr, "kernel_launch: grid %d (%d CUs x %d)\n", grid, cus, per_cu);
    }
    if (grid < 0) return;
    Params p{};
    for (int i = 0; i < 14; ++i) p.in[i] = (const float*)d_in[i];
    p.out = (float*)d_out; p.ws = (unsigned char*)d_ws;
    void* args[] = {&p};
    hipError_t e = hipLaunchCooperativeKernel((const void*)fwd_kernel, dim3(grid), dim3(512), args, LDS_BYTES, stream);
    if (e != hipSuccess) fprintf(stderr, "kernel_launch: cooperative launch failed: %s (grid %d)\n", hipGetErrorString(e), grid);
}
```

```cpp
#include <hip/hip_runtime.h>
#include <hip/hip_cooperative_groups.h>
#include <cstdio>
#include <cstdint>
namespace cg = cooperative_groups;
constexpr int DM = 1024, BATCH = 32, SEQ = 2048, MROWS = BATCH * SEQ, DFF = 2816, NGU = 2 * DFF, NIN = 3072, INW = 3076, NREL = 513;
constexpr float RMS_EPS = 1e-6f, LOG2E = 1.4426950408889634f;

#ifndef PG8_WGM
#define PG8_WGM 8
#endif
namespace pg8 {
#define PG8_LAS __attribute__((address_space(3)))
typedef unsigned short bf16_t;
typedef short bf16x8 __attribute__((ext_vector_type(8)));
typedef float f32x4 __attribute__((ext_vector_type(4)));
typedef unsigned u32x4 __attribute__((ext_vector_type(4)));
constexpr int BM = 256, BK = 64, HALF = 128, HTB = HALF * BK * 2  , STAGE_BYTES = 8 * HTB, NXCD = 8, WGM = PG8_WGM;

__host__ __device__ __forceinline__ int lds_byte(int r, int c) { const int st = (r >> 4) * 2 + (c >> 5), rr = r & 15, cc = c & 31, ob = rr * 64 + cc * 2; return st * 1024 + (ob ^ (((ob >> 9) & 1) << 5)); }
__host__ __device__ __forceinline__ void stage_rc(int b, int& R, int& C) { const int st = b / 1024, sb = b % 1024, swz = sb ^ (((sb >> 9) & 1) << 5); R = (st >> 1) * 16 + swz / 64; C = (st & 1) * 32 + (swz % 64) / 2; }
__host__ __device__ __forceinline__ int perm32(int rho) { const int n = rho >> 4, i = rho & 15; return 8 * (i >> 2) + 4 * n + (i & 3); }

struct Unit { int pm, pn, pass; };
struct Gemm { const bf16_t* A; const bf16_t* Bt; int M, N, K; };

struct StaticOrder {
    int nM, nN, nwg, G, c, rep = 1;
    __host__ __device__ void init(int M, int N, int G_, int c_) { nM = M / BM; nN = N / BM; nwg = nM * nN; G = G_; c = c_; }
    __host__ __device__ bool next(int i, Unit& u) const {
        const long L = (long)i * G + c; if (L >= (long)nwg * rep) return false;
        int wgid = (int)(L % nwg); u.pass = (int)(L / nwg); { const int q = nwg / NXCD, r = nwg % NXCD, xcd = wgid % NXCD, off = wgid / NXCD; wgid = (xcd < r ? xcd * (q + 1) : r * (q + 1) + (xcd - r) * q) + off; }
        const int nig = WGM * nN, gid = wgid / nig, fm = gid * WGM, gsz = (nM - fm) < WGM ? (nM - fm) : WGM;
        u.pm = fm + ((wgid % nig) % gsz); u.pn = (wgid % nig) / gsz; return true;
    }
    __device__ __forceinline__ void a_ready(const Unit&) const {}
    __device__ __forceinline__ void done(const Unit&) const {}
};

__device__ __forceinline__ unsigned cvt_pk_bf16(float lo, float hi) { unsigned r; asm volatile("v_cvt_pk_bf16_f32 %0, %1, %2" : "=v"(r) : "v"(lo), "v"(hi)); return r; }
__device__ __forceinline__ float fq_sum(float v) {
    auto a = __builtin_amdgcn_permlane16_swap(__float_as_uint(v), __float_as_uint(v), false, false);
    const float s = __uint_as_float(a[0]) + __uint_as_float(a[1]);
    auto b = __builtin_amdgcn_permlane32_swap(__float_as_uint(s), __float_as_uint(s), false, false);
    return __uint_as_float(b[0]) + __uint_as_float(b[1]);
}
__device__ __forceinline__ float row_rs(const float* SS, int row, int fq) {
    const f32x4 sv = *(const f32x4*)(SS + (size_t)row * 16 + 4 * fq);
    float s = (sv[0] + sv[1]) + (sv[2] + sv[3]);
    s += __shfl_xor(s, 16); s += __shfl_xor(s, 32);
    return __builtin_amdgcn_rsqf(s * (1.0f / DM) + RMS_EPS);
}
__device__ __forceinline__ void row_rs8(const float* SS, int row0, int fq, float (&rs)[2][4]) {
    f32x4 sv[2][4];
#pragma unroll
    for (int ai = 0; ai < 2; ++ai)
#pragma unroll
        for (int m = 0; m < 4; ++m) sv[ai][m] = *(const f32x4*)(SS + (size_t)(row0 + ai * HALF + m * 16) * 16 + 4 * fq);
#pragma unroll
    for (int ai = 0; ai < 2; ++ai)
#pragma unroll
        for (int m = 0; m < 4; ++m) {
            float s = (sv[ai][m][0] + sv[ai][m][1]) + (sv[ai][m][2] + sv[ai][m][3]);
            s += __shfl_xor(s, 16); s += __shfl_xor(s, 32);
            rs[ai][m] = __builtin_amdgcn_rsqf(s * (1.0f / DM) + RMS_EPS);
        }
    asm volatile("" ::: "memory");
}
__device__ __forceinline__ void row_rs8_lds(const PG8_LAS unsigned char* rsl, int rowl0, int fq, float (&rs)[2][4]) {
    f32x4 sv[2][4];
#pragma unroll
    for (int ai = 0; ai < 2; ++ai)
#pragma unroll
        for (int m = 0; m < 4; ++m) sv[ai][m] = *(const PG8_LAS f32x4*)(rsl + (rowl0 + ai * HALF + m * 16) * 64 + fq * 16);
#pragma unroll
    for (int ai = 0; ai < 2; ++ai)
#pragma unroll
        for (int m = 0; m < 4; ++m) rs[ai][m] = __builtin_amdgcn_rsqf(fq_sum((sv[ai][m][0] + sv[ai][m][1]) + (sv[ai][m][2] + sv[ai][m][3])) * (1.0f / DM) + RMS_EPS);
}
__device__ __forceinline__ void stage_rs_lds(const float* SS, PG8_LAS unsigned char* rsl, const Unit& u, int tid, int wid) {
    const int lane = tid & 63;
#pragma unroll
    for (int j = 0; j < 2; ++j) {
        const float* src = SS + (size_t)(u.pm * BM + 32 * wid + 16 * j + (lane >> 2)) * 16 + 4 * (lane & 3);
        __builtin_amdgcn_global_load_lds((const unsigned*)src, (PG8_LAS unsigned*)(rsl + (2 * wid + j) * 1024), 16, 0, 0);
    }
}
struct EpiGU {
    static constexpr bool PERM = true, AFTER_DRAIN = false, PREFETCH = false, IDEMPOTENT = true, RS_LDS = true;
    bf16_t* O; const float* SS; PG8_LAS unsigned char* rsl;
    __device__ __forceinline__ void stage_rs(const Unit& u, int tid, int wid) const { stage_rs_lds(SS, rsl, u, tid, wid); }
    __device__ __forceinline__ void operator()(const f32x4 (&acc)[2][2][4][2], const Unit& u, int wr, int wc, int fr, int fq) const {
        const int row0 = u.pm * BM + wr * 64 + fr, col0 = u.pn * 128 + wc * 32 + 8 * fq;
        float rsv[2][4]; row_rs8_lds(rsl, wr * 64 + fr, fq, rsv);
#pragma unroll
        for (int ai = 0; ai < 2; ++ai)
#pragma unroll
            for (int m = 0; m < 4; ++m) {
                const int row = row0 + ai * HALF + m * 16;
                const float rs = rsv[ai][m];
                f32x4 av[2];
#pragma unroll
                for (int n = 0; n < 2; ++n) {
                    const f32x4 g = acc[ai][0][m][n] * rs, up = acc[ai][1][m][n] * rs, t = g * (-LOG2E);
                    f32x4 d; d[0] = __builtin_amdgcn_exp2f(t[0]); d[1] = __builtin_amdgcn_exp2f(t[1]); d[2] = __builtin_amdgcn_exp2f(t[2]); d[3] = __builtin_amdgcn_exp2f(t[3]);
                    d = d + 1.0f;
                    f32x4 r; r[0] = __builtin_amdgcn_rcpf(d[0]); r[1] = __builtin_amdgcn_rcpf(d[1]); r[2] = __builtin_amdgcn_rcpf(d[2]); r[3] = __builtin_amdgcn_rcpf(d[3]);
                    av[n] = (g * up) * r;
                }
                u32x4 w; w.x = cvt_pk_bf16(av[0][0], av[0][1]); w.y = cvt_pk_bf16(av[0][2], av[0][3]); w.z = cvt_pk_bf16(av[1][0], av[1][1]); w.w = cvt_pk_bf16(av[1][2], av[1][3]);
                *(u32x4*)(O + (size_t)row * DFF + col0) = w;
            }
    }
};
struct EpiQKV {
    static constexpr bool PERM = true, AFTER_DRAIN = false, PREFETCH = false, IDEMPOTENT = true, RS_LDS = true;
    bf16_t* O; const float* SS; PG8_LAS unsigned char* rsl; unsigned* KM;
    __device__ __forceinline__ void stage_rs(const Unit& u, int tid, int wid) const { stage_rs_lds(SS, rsl, u, tid, wid); }
    __device__ __forceinline__ void operator()(const f32x4 (&acc)[2][2][4][2], const Unit& u, int wr, int wc, int fr, int fq) const {
        const int row0 = u.pm * BM + wr * 64 + fr, col0 = u.pn * BM + wc * 32 + 8 * fq;
        float cs = 1.0f;
        if (u.pn % 3 == 0) cs = (u.pn == 6) ? 0.17677669529663687f * LOG2E : 0.125f * LOG2E;
        float rsv[2][4]; row_rs8_lds(rsl, wr * 64 + fr, fq, rsv);
        const bool kn = (u.pn == 1) || (u.pn == 7);
        float mx[2] = {0.f, 0.f};
#pragma unroll
        for (int ai = 0; ai < 2; ++ai)
#pragma unroll
            for (int m = 0; m < 4; ++m) {
                const int row = row0 + ai * HALF + m * 16;
                const float rs = rsv[ai][m] * cs;
#pragma unroll
                for (int bj = 0; bj < 2; ++bj) {
                    const f32x4 v0 = acc[ai][bj][m][0] * rs, v1 = acc[ai][bj][m][1] * rs;
                    if (kn) { const float ss = fq_sum(((v0[0] * v0[0] + v0[1] * v0[1]) + (v0[2] * v0[2] + v0[3] * v0[3])) + ((v1[0] * v1[0] + v1[1] * v1[1]) + (v1[2] * v1[2] + v1[3] * v1[3]))); mx[bj] = fmaxf(mx[bj], ss); }
                    u32x4 w; w.x = cvt_pk_bf16(v0[0], v0[1]); w.y = cvt_pk_bf16(v0[2], v0[3]); w.z = cvt_pk_bf16(v1[0], v1[1]); w.w = cvt_pk_bf16(v1[2], v1[3]);
                    *(u32x4*)(O + (size_t)row * NIN + col0 + bj * HALF) = w;
                }
            }
        if (kn) {
#pragma unroll
            for (int bj = 0; bj < 2; ++bj) {
                float v = mx[bj];
#pragma unroll
                for (int o = 1; o < 16; o <<= 1) v = fmaxf(v, __shfl_xor(v, o));
                if (fr == 0 && fq == 0) atomicMax(KM + ((((u.pn == 7) ? 32 : 0) + (u.pm >> 3)) * 4 + 2 * bj + (wc >> 1)) * 2 + (wc & 1), __float_as_uint(v));
            }
        }
    }
};
struct EpiRes {
    static constexpr bool PERM = true, AFTER_DRAIN = false, PREFETCH = false, IDEMPOTENT = false, RS_LDS = false;
    bf16_t* xb; float* SS; float alpha;
    __device__ __forceinline__ void operator()(const f32x4 (&acc)[2][2][4][2], const Unit& u, int wr, int wc, int fr, int fq) const {
        const int row0 = u.pm * BM + wr * 64 + fr, col0 = u.pn * BM + wc * 32 + 8 * fq;
        const float alpha = (u.pass & 1) ? -this->alpha : this->alpha;
#pragma unroll
        for (int ai = 0; ai < 2; ++ai) {
            u32x4 bb[4][2];
#pragma unroll
            for (int m = 0; m < 4; ++m)
#pragma unroll
                for (int bj = 0; bj < 2; ++bj) bb[m][bj] = *(const u32x4*)(xb + (size_t)(row0 + ai * HALF + m * 16) * DM + col0 + bj * HALF);
            asm volatile("" ::: "memory");
#pragma unroll
            for (int m = 0; m < 4; ++m) {
                const int row = row0 + ai * HALF + m * 16;
                bf16_t* xp = xb + (size_t)row * DM + col0;
                float ssq = 0.f;
#pragma unroll
                for (int bj = 0; bj < 2; ++bj) {
                    const u32x4 b = bb[m][bj];
                    float v[8];
#pragma unroll
                    for (int j = 0; j < 4; ++j) {
                        v[2 * j] = __uint_as_float(b[j] << 16) + acc[ai][bj][m][j >> 1][(2 * j) & 3] * alpha;
                        v[2 * j + 1] = __uint_as_float(b[j] & 0xffff0000u) + acc[ai][bj][m][j >> 1][(2 * j + 1) & 3] * alpha;
                    }
                    u32x4 w; w.x = cvt_pk_bf16(v[0], v[1]); w.y = cvt_pk_bf16(v[2], v[3]); w.z = cvt_pk_bf16(v[4], v[5]); w.w = cvt_pk_bf16(v[6], v[7]);
                    *(u32x4*)(xp + bj * HALF) = w;
#pragma unroll
                    for (int j = 0; j < 4; ++j) { const float r0 = __uint_as_float(w[j] << 16), r1 = __uint_as_float(w[j] & 0xffff0000u); ssq += r0 * r0 + r1 * r1; }
                }
                ssq = fq_sum(ssq);
                if (fq == 0) SS[(size_t)row * 16 + u.pn * 4 + wc] = ssq;
            }
        }
    }
};
template <class Epi, class Sched, bool ALIGN_EPI = false, bool SP2 = false>
__device__ __forceinline__ void gemm_phase(PG8_LAS unsigned char* lds, const Gemm g, const Sched& S, const Epi& E, const int tid) {
    const int wid = __builtin_amdgcn_readfirstlane(tid >> 6), lane = tid & 63, wr = wid >> 2, wc = wid & 3, fr = lane & 15, fq = lane >> 4;
    const int K = g.K, nt = K / BK;
    unsigned voffA[2], voffB[2];
#pragma unroll
    for (int i = 0; i < 2; ++i) { int R, C; stage_rc(tid * 16 + i * 8192, R, C); const int Rb = Epi::PERM ? ((R & ~31) + perm32(R & 31)) : R;
        voffA[i] = (unsigned)(R * K + C) * 2u; voffB[i] = (unsigned)(Rb * K + C) * 2u; }
    const size_t kstep = (size_t)(BK * 2);
    const size_t hstep = (size_t)HALF * K * 2;
    const size_t tstep = 2 * hstep;
    const unsigned ldsw = (unsigned)wid * 1024u;
    const int aoff = lds_byte(wr * 64 + fr, fq * 8), boff = lds_byte(wc * 32 + fr, fq * 8);
#define PG8_SA(b, h) (((b) * 2 + (h)) * HTB)
#define PG8_SB(b, h) ((4 + (b) * 2 + (h)) * HTB)
#define PG8_STAGE(bufoff, gbase, voff) do { _Pragma("unroll") for (int _i = 0; _i < 2; ++_i) \
        __builtin_amdgcn_global_load_lds((const unsigned*)((const char*)(gbase) + (voff)[_i]), (PG8_LAS unsigned*)(lds + (bufoff) + ldsw + _i * 8192), 16, 0, 0); } while (0)
#define PG8_LDA(dst, b, h) do { _Pragma("unroll") for (int m = 0; m < 4; ++m) _Pragma("unroll") for (int k = 0; k < 2; ++k) dst[m][k] = *(const PG8_LAS bf16x8*)(lds + PG8_SA(b, h) + aoff + m * 2048 + k * 1024); } while (0)
#define PG8_LDB(dst, b, h) do { _Pragma("unroll") for (int n = 0; n < 2; ++n) _Pragma("unroll") for (int k = 0; k < 2; ++k) dst[n][k] = *(const PG8_LAS bf16x8*)(lds + PG8_SB(b, h) + boff + n * 2048 + k * 1024); } while (0)
#define PG8_MMA(ai, bj, At, Bt) do { __builtin_amdgcn_s_setprio(1); _Pragma("unroll") for (int m = 0; m < 4; ++m) _Pragma("unroll") for (int n = 0; n < 2; ++n) _Pragma("unroll") for (int k = 0; k < 2; ++k) \
        acc[ai][bj][m][n] = __builtin_amdgcn_mfma_f32_16x16x32_bf16(Bt[n][k], At[m][k], acc[ai][bj][m][n], 0, 0, 0); __builtin_amdgcn_s_setprio(0); } while (0)
#define PG8_WAIT_V(n) asm volatile("s_waitcnt vmcnt(" #n ")" ::: "memory")
#define PG8_WAIT_L(n) asm volatile("s_waitcnt lgkmcnt(" #n ")" ::: "memory")
#define PG8_BAR __builtin_amdgcn_s_barrier()
#define PG8_SCHED __builtin_amdgcn_sched_barrier(0)
    Unit cur, nxt; int ui = 0;
    if (!S.next(0, cur)) return;
    f32x4 acc[2][2][4][2];
#pragma unroll
    for (int a = 0; a < 2; ++a)
#pragma unroll
        for (int b = 0; b < 2; ++b)
#pragma unroll
            for (int m = 0; m < 4; ++m)
#pragma unroll
                for (int n = 0; n < 2; ++n) acc[a][b][m][n] = (f32x4){0.f, 0.f, 0.f, 0.f};
    bf16x8 At[4][2], B0[2][2], B1[2][2];
    const char* cA = (const char*)g.A + (size_t)cur.pm * tstep; const char* cB = (const char*)g.Bt + (size_t)cur.pn * tstep;
    S.a_ready(cur);
    if constexpr (SP2) {
        PG8_STAGE(PG8_SB(0, 0), cB, voffB); PG8_STAGE(PG8_SB(0, 1), cB + hstep, voffB); PG8_STAGE(PG8_SA(0, 0), cA, voffA); PG8_STAGE(PG8_SA(0, 1), cA + hstep, voffA);
        if (wr == 1) PG8_BAR;
        PG8_WAIT_V(2); PG8_BAR;
        PG8_STAGE(PG8_SB(1, 0), cB + kstep, voffB); PG8_STAGE(PG8_SA(1, 0), cA + kstep, voffA); PG8_STAGE(PG8_SB(1, 1), cB + hstep + kstep, voffB);
        PG8_WAIT_V(6); PG8_BAR;
    } else {
        PG8_STAGE(PG8_SB(0, 0), cB, voffB); PG8_STAGE(PG8_SA(0, 0), cA, voffA); PG8_STAGE(PG8_SB(0, 1), cB + hstep, voffB); PG8_STAGE(PG8_SA(0, 1), cA + hstep, voffA);
        if (wr == 1) PG8_BAR;
        PG8_WAIT_V(4); PG8_BAR;
        PG8_STAGE(PG8_SB(1, 0), cB + kstep, voffB); PG8_STAGE(PG8_SA(1, 0), cA + kstep, voffA); PG8_STAGE(PG8_SB(1, 1), cB + hstep + kstep, voffB);
        PG8_WAIT_V(6); PG8_BAR;
    }
    for (;;) {
        const bool has_next = S.next(ui + 1, nxt);
        const char* nA = has_next ? (const char*)g.A + (size_t)nxt.pm * tstep : cA; const char* nB = has_next ? (const char*)g.Bt + (size_t)nxt.pn * tstep : cB;
        for (int t = 0; t < nt; t += 2) {
            const bool last = (t == nt - 2);
            if constexpr (Epi::RS_LDS) { if (t == nt - 4) E.stage_rs(cur, tid, wid); }
            if constexpr (Epi::PREFETCH) { if (t >= nt - 8) E.prefetch(cur, lds, tid, wid, (t - (nt - 8)) >> 1); }
            const char* a1 = cA + (size_t)(t + 1) * kstep;
            const char* a2 = last ? nA : cA + (size_t)(t + 2) * kstep; const char* b2 = last ? nB : cB + (size_t)(t + 2) * kstep;
            const char* a3 = a2 + kstep; const char* b3 = b2 + kstep;
            if (last && has_next) S.a_ready(nxt);
            if constexpr (SP2) {
            PG8_LDB(B0, 0, 0); PG8_LDB(B1, 0, 1); PG8_SCHED; PG8_LDA(At, 0, 0); PG8_STAGE(PG8_SA(1, 1), a1 + hstep, voffA);
            PG8_WAIT_V(8); PG8_WAIT_L(0); PG8_BAR; PG8_MMA(0, 0, At, B0); PG8_MMA(0, 1, At, B1); PG8_BAR; PG8_SCHED;
            PG8_LDA(At, 0, 1); PG8_STAGE(PG8_SB(0, 0), b2, voffB); PG8_STAGE(PG8_SB(0, 1), b2 + hstep, voffB); PG8_STAGE(PG8_SA(0, 0), a2, voffA);
            PG8_WAIT_V(8); PG8_WAIT_L(0); PG8_BAR; PG8_MMA(1, 0, At, B0); PG8_MMA(1, 1, At, B1); PG8_BAR; PG8_SCHED;
            PG8_LDB(B0, 1, 0); PG8_LDB(B1, 1, 1); PG8_SCHED; PG8_LDA(At, 1, 0); PG8_STAGE(PG8_SA(0, 1), a2 + hstep, voffA);
            PG8_WAIT_V(8); PG8_WAIT_L(0); PG8_BAR; PG8_MMA(0, 0, At, B0); PG8_MMA(0, 1, At, B1); PG8_BAR; PG8_SCHED;
            PG8_LDA(At, 1, 1); PG8_STAGE(PG8_SB(1, 0), b3, voffB); PG8_STAGE(PG8_SB(1, 1), b3 + hstep, voffB); PG8_STAGE(PG8_SA(1, 0), a3, voffA);
            PG8_WAIT_V(8); PG8_WAIT_L(0); PG8_BAR; PG8_MMA(1, 0, At, B0); PG8_MMA(1, 1, At, B1); PG8_BAR; PG8_SCHED;
            } else {
            PG8_LDB(B0, 0, 0); PG8_SCHED; PG8_LDA(At, 0, 0); PG8_STAGE(PG8_SA(1, 1), a1 + hstep, voffA);
            PG8_WAIT_L(8); PG8_BAR; PG8_WAIT_L(0); PG8_MMA(0, 0, At, B0); PG8_BAR; PG8_SCHED;
            PG8_LDB(B1, 0, 1); PG8_STAGE(PG8_SB(0, 0), b2, voffB);
            PG8_BAR; PG8_WAIT_L(0); PG8_MMA(0, 1, At, B1); PG8_BAR;
            PG8_LDA(At, 0, 1); PG8_STAGE(PG8_SA(0, 0), a2, voffA);
            PG8_BAR; PG8_WAIT_L(0); PG8_MMA(1, 0, At, B0); PG8_BAR; PG8_SCHED;
            PG8_STAGE(PG8_SB(0, 1), b2 + hstep, voffB);
            PG8_WAIT_V(6); PG8_BAR; PG8_MMA(1, 1, At, B1); PG8_BAR;
            PG8_LDB(B0, 1, 0); PG8_SCHED; PG8_LDA(At, 1, 0); PG8_STAGE(PG8_SA(0, 1), a2 + hstep, voffA);
            PG8_WAIT_L(8); PG8_BAR; PG8_WAIT_L(0); PG8_MMA(0, 0, At, B0); PG8_BAR; PG8_SCHED;
            PG8_LDB(B1, 1, 1); PG8_STAGE(PG8_SB(1, 0), b3, voffB);
            PG8_BAR; PG8_WAIT_L(0); PG8_MMA(0, 1, At, B1); PG8_BAR;
            PG8_LDA(At, 1, 1); PG8_STAGE(PG8_SA(1, 0), a3, voffA);
            PG8_BAR; PG8_WAIT_L(0); PG8_MMA(1, 0, At, B0); PG8_BAR; PG8_SCHED;
            PG8_STAGE(PG8_SB(1, 1), b3 + hstep, voffB);
            PG8_WAIT_V(6); PG8_BAR; PG8_MMA(1, 1, At, B1); PG8_BAR;
            }
        }
        if constexpr (ALIGN_EPI) { if (wr == 0) PG8_BAR; }
        if constexpr (!Epi::AFTER_DRAIN) { E(acc, cur, wr, wc, fr, fq);
#ifdef EPI_TWICE
            if constexpr (Epi::IDEMPOTENT) { asm volatile("" ::: "memory"); E(acc, cur, wr, wc, fr, fq); }
#endif
            S.done(cur); }
        if (!has_next) break;
#pragma unroll
        for (int a = 0; a < 2; ++a)
#pragma unroll
            for (int b = 0; b < 2; ++b)
#pragma unroll
                for (int m = 0; m < 4; ++m)
#pragma unroll
                    for (int n = 0; n < 2; ++n) acc[a][b][m][n] = (f32x4){0.f, 0.f, 0.f, 0.f};
        cur = nxt; cA = nA; cB = nB; ++ui;
        if constexpr (ALIGN_EPI) { if (wr == 1) PG8_BAR; }
    }
    PG8_WAIT_V(0);
    if constexpr (!ALIGN_EPI) { if (wr == 0) PG8_BAR; }
    PG8_BAR;
    if constexpr (Epi::AFTER_DRAIN) { E.fused(acc, cur, wr, wc, fr, fq, lds, wid, lane); S.done(cur); }
#undef PG8_SA
#undef PG8_SB
#undef PG8_STAGE
#undef PG8_LDA
#undef PG8_LDB
#undef PG8_MMA
#undef PG8_WAIT_V
#undef PG8_WAIT_L
#undef PG8_BAR
#undef PG8_SCHED
}
}
#define LAS __attribute__((address_space(3)))
namespace att {
using pg8::bf16_t;
typedef short bf16x8 __attribute__((ext_vector_type(8)));
typedef short s16x4 __attribute__((ext_vector_type(4)));
typedef float f32x16 __attribute__((ext_vector_type(16)));
typedef float f32x4 __attribute__((ext_vector_type(4)));
typedef unsigned u32x4 __attribute__((ext_vector_type(4)));
typedef float f32x2_t __attribute__((ext_vector_type(2))); typedef __bf16 bf16x2_t __attribute__((ext_vector_type(2)));
typedef short v4i16_t __attribute__((ext_vector_type(4)));
constexpr int K_OFF = 0, V_OFF = 16384, FS_OFF = 32768, EXT_OFF = 33280, PFX_OFF = 35840, MISC_OFF = 35904, WSF_OFF = 36864, STG_OFF = 40960, STG_PITCH = 68;
constexpr int ATT_LDS_END = STG_OFF + 8 * 32 * STG_PITCH * 4;
static_assert(ATT_LDS_END <= 131072, "attention LDS map");

__device__ __forceinline__ unsigned cvtpk(float lo, float hi) { f32x2_t v = {lo, hi}; bf16x2_t b = __builtin_convertvector(v, bf16x2_t); return __builtin_bit_cast(unsigned, b); }
__device__ __forceinline__ void lohi(float v, float& lo, float& hi_) {
    auto rr = __builtin_amdgcn_permlane32_swap(__float_as_uint(v), __float_as_uint(v), false, false);
    lo = __uint_as_float(rr[0]); hi_ = __uint_as_float(rr[1]);
}
__device__ __forceinline__ float pair_sum(float v) { float a, b; lohi(v, a, b); return a + b; }
__device__ __forceinline__ float pair_max(float v) { float a, b; lohi(v, a, b); return fmaxf(a, b); }
__device__ __forceinline__ s16x4 vtr(const LAS unsigned char* p) { return __builtin_bit_cast(s16x4, __builtin_amdgcn_ds_read_tr16_b64_v4i16((LAS v4i16_t*)p)); }

__device__ __forceinline__ void pv(f32x16 (&o)[2], const LAS unsigned char* vp, const f32x16& p0, const f32x16& p1) {
    u32x4 pw[4];
    pw[0] = (u32x4){cvtpk(p0[0], p0[1]), cvtpk(p0[2], p0[3]), cvtpk(p0[4], p0[5]), cvtpk(p0[6], p0[7])};
    pw[1] = (u32x4){cvtpk(p0[8], p0[9]), cvtpk(p0[10], p0[11]), cvtpk(p0[12], p0[13]), cvtpk(p0[14], p0[15])};
    pw[2] = (u32x4){cvtpk(p1[0], p1[1]), cvtpk(p1[2], p1[3]), cvtpk(p1[4], p1[5]), cvtpk(p1[6], p1[7])};
    pw[3] = (u32x4){cvtpk(p1[8], p1[9]), cvtpk(p1[10], p1[11]), cvtpk(p1[12], p1[13]), cvtpk(p1[14], p1[15])};
#pragma unroll
    for (int dh = 0; dh < 2; ++dh)
#pragma unroll
        for (int ks = 0; ks < 4; ++ks) {
            const s16x4 lo = vtr(vp + dh * 4096 + ks * 1024), hi_ = vtr(vp + dh * 4096 + ks * 1024 + 512);
            const bf16x8 vf = __builtin_shufflevector(lo, hi_, 0, 1, 2, 3, 4, 5, 6, 7);
            o[dh] = __builtin_amdgcn_mfma_f32_32x32x16_bf16(__builtin_bit_cast(bf16x8, pw[ks]), vf, o[dh], 0, 0, 0);
        }
}
__device__ __forceinline__ void softmax_pv(f32x16& p0, f32x16& p1, float& m, float& l, f32x16 (&o)[2], LAS float* wsf, const LAS unsigned char* vp, int r32, int hi) {
    float rm = fmaxf(p0[0], p1[0]);
#pragma unroll
    for (int r = 1; r < 16; ++r) rm = fmaxf(rm, fmaxf(p0[r], p1[r]));
    rm = pair_max(rm);
    if (__all(rm - m < -151.0f)) return;
    const float mnew = fmaxf(m, rm), alpha = __builtin_amdgcn_exp2f(m - mnew);
    m = mnew;
    float s = 0.f;
#pragma unroll
    for (int r = 0; r < 16; ++r) { p0[r] = __builtin_amdgcn_exp2f(p0[r] - mnew); p1[r] = __builtin_amdgcn_exp2f(p1[r] - mnew); s += p0[r] + p1[r]; }
    l = l * alpha + s;
    if (__any(alpha != 1.0f)) {
        if (hi == 0) wsf[r32] = alpha;
#pragma unroll
        for (int r = 0; r < 16; ++r) { const float f = wsf[(r & 3) + 8 * (r >> 2) + 4 * hi]; o[0][r] *= f; o[1][r] *= f; }
    }
    pv(o, vp, p0, p1);
}
__device__ __forceinline__ void o_rows(const f32x16 (&o)[2], LAS float* stg, int r32, int hi, f32x4 (&x)[8]) {
#pragma unroll
    for (int r = 0; r < 16; ++r) { const int q = (r & 3) + 8 * (r >> 2) + 4 * hi; stg[q * STG_PITCH + r32] = o[0][r]; stg[q * STG_PITCH + 32 + r32] = o[1][r]; }
#pragma unroll
    for (int i = 0; i < 8; ++i) x[i] = *(const LAS f32x4*)(stg + r32 * STG_PITCH + 32 * hi + 4 * i);
}
__device__ __forceinline__ void store_row(bf16_t* op, const f32x4 (&x)[8]) {
#pragma unroll
    for (int i = 0; i < 4; ++i) {
        u32x4 w; w.x = cvtpk(x[2 * i][0], x[2 * i][1]); w.y = cvtpk(x[2 * i][2], x[2 * i][3]); w.z = cvtpk(x[2 * i + 1][0], x[2 * i + 1][1]); w.w = cvtpk(x[2 * i + 1][2], x[2 * i + 1][3]);
        *(u32x4*)(op + 8 * i) = w;
    }
}

template <bool MASK>
__device__ __forceinline__ void sb_weights(f32x16& p0, f32x16& p1, float tlf, int hi, float& R) {
    float Tm[8];
#pragma unroll
    for (int hf = 0; hf < 2; ++hf)
#pragma unroll
        for (int a = 0; a < 4; ++a) {
            float om[4], be[4];
#pragma unroll
            for (int j = 0; j < 4; ++j) {
                const float z = hf ? p1[4 * a + j] : p0[4 * a + j];
                const float o_ = __builtin_amdgcn_rcpf(1.0f + __builtin_amdgcn_exp2f(z));
                if (MASK) { const float vf_ = __builtin_amdgcn_fmed3f(tlf - (float)(32 * hf + 8 * a + j), 0.f, 1.f), dl = o_ - 1.0f; om[j] = __builtin_fmaf(vf_, dl, 1.0f); be[j] = -vf_ * dl; }
                else { om[j] = o_; be[j] = 1.0f - o_; }
            }
            const float s2 = om[3], s1 = om[3] * om[2], s0 = s1 * om[1];
            Tm[4 * hf + a] = s0 * om[0];
            if (hf) { p1[4 * a + 3] = be[3]; p1[4 * a + 2] = be[2] * s2; p1[4 * a + 1] = be[1] * s1; p1[4 * a] = be[0] * s0; }
            else    { p0[4 * a + 3] = be[3]; p0[4 * a + 2] = be[2] * s2; p0[4 * a + 1] = be[1] * s1; p0[4 * a] = be[0] * s0; }
        }
    float U[8], Th[8], PS[8];
#pragma unroll
    for (int k = 0; k < 8; ++k) { float lo_; lohi(Tm[k], lo_, Th[k]); U[k] = lo_ * Th[k]; }
    PS[7] = 1.0f;
#pragma unroll
    for (int k = 6; k >= 0; --k) PS[k] = PS[k + 1] * U[k + 1];
#pragma unroll
    for (int k = 0; k < 8; ++k) {
        const float Bk = PS[k] * (hi ? 1.0f : Th[k]) * R;
#pragma unroll
        for (int j = 0; j < 4; ++j) { if (k < 4) p0[4 * k + j] *= Bk; else p1[4 * (k - 4) + j] *= Bk; }
    }
    R *= PS[0] * U[0];
}

struct AttnArgs { const bf16_t* QKV; bf16_t* MIX; const float* LFC; const float* CT; const float* EXT; const float* KM; float lam, one_minus_li; };

template <int VAR>
__device__ __forceinline__ void attn_unit(LAS unsigned char* lds, const AttnArgs& A, int b, int h, int qb, const int tid) {
    const int lane = tid & 63, r32 = lane & 31, hi = lane >> 5;
    const int wid = __builtin_amdgcn_readfirstlane(tid >> 6);
    const int q0 = qb * 256, qw0 = q0 + 32 * wid, t = qw0 + r32, Lw = qw0 >> 6;
    const size_t rowbase = (size_t)b * SEQ;
    const bf16_t* Qp = A.QKV + rowbase * NIN + 768 * VAR + 64 * h;
    const bf16_t* Kp = Qp + 256; const bf16_t* Vp = Qp + 512;
    LAS float* FS = (LAS float*)(lds + FS_OFF);
    LAS float* EXTL = (LAS float*)(lds + EXT_OFF);
    LAS float* PFX = (LAS float*)(lds + PFX_OFF);
    LAS float* wsf = (LAS float*)(lds + WSF_OFF) + wid * 64;
    LAS float* stg = (LAS float*)(lds + STG_OFF) + wid * (32 * STG_PITCH);

    int first, n, step;
    if (VAR == 1) { const int lo_ = (4 * qb - 8) > 0 ? (4 * qb - 8) : 0; first = 4 * qb + 3; n = 4 * qb + 4 - lo_; step = -1; }
    else { first = 4 * qb + 3; n = 4 * qb + 4; step = -1; }

    if (VAR == 0) {
        if (tid < 8) { float s = 0.f; for (int c = 0; c < tid; ++c) s += A.CT[(b * 8 + c) * 4 + h]; PFX[tid] = s; }
        __syncthreads();
    }
    if (VAR == 1) { for (int i = tid; i < 640; i += 512) EXTL[i] = A.EXT[h * 640 + i]; }

    bf16x8 qr[4];
#pragma unroll
    for (int d0 = 0; d0 < 4; ++d0) qr[d0] = *(const bf16x8*)(Qp + (size_t)t * NIN + d0 * 16 + hi * 8);
    const bf16_t* ksrc = Kp + (size_t)lane * NIN + wid * 8;
    const bf16_t* vsrc = Vp + (size_t)(16 * (wid & 3) + (lane >> 2)) * NIN + (wid >> 2) * 32 + (lane & 3) * 8;
    const float* fsrc = A.LFC + (rowbase + (size_t)(tid & 63)) * 4 + h;
    u32x4 kreg, vreg; float freg = 0.f;
#define ATT_LOAD(i) do { const int kt_ = first + (i) * step; kreg = *(const u32x4*)(ksrc + (size_t)kt_ * 64 * NIN); vreg = *(const u32x4*)(vsrc + (size_t)kt_ * 64 * NIN); \
        if (VAR == 0 && tid < 64) freg = fsrc[(size_t)kt_ * 256] + PFX[kt_ >> 2]; } while (0)
#define ATT_STORE(bf) do { *(LAS u32x4*)(lds + K_OFF + (bf) * 8192 + wid * 1024 + lane * 16) = kreg; *(LAS u32x4*)(lds + V_OFF + (bf) * 8192 + wid * 1024 + lane * 16) = vreg; \
        if (VAR == 0 && tid < 64) FS[(bf) * 64 + tid] = freg; } while (0)

    float m1 = -1e30f, l1 = 0.f, m2 = -1e30f, l2 = 0.f, R = 1.f;
    bool wdone = false;
    LAS unsigned* DONE = (LAS unsigned*)(lds + MISC_OFF + 64);
    f32x16 o[2], o2[2];
#pragma unroll
    for (int r = 0; r < 16; ++r) { o[0][r] = 0.f; o[1][r] = 0.f; o2[0][r] = 0.f; o2[1][r] = 0.f; }
    float Ft = 0.f;
    if (VAR == 0) Ft = A.LFC[(rowbase + t) * 4 + h] + PFX[qb];
    const float slope2 = (VAR == 2) ? __builtin_amdgcn_exp2f(-2.0f * (float)(h + 1)) * LOG2E : 0.f;
    float qkb1 = 0.f, qkb2 = 0.f;
    if (VAR == 0 || VAR == 2) {
        float s1 = 0.f, s2 = 0.f;
#pragma unroll
        for (int d0 = 0; d0 < 4; ++d0)
#pragma unroll
            for (int j = 0; j < 4; ++j) {
                const unsigned w = __builtin_bit_cast(u32x4, qr[d0])[j];
                const float a0 = __uint_as_float(w << 16), a1 = __uint_as_float(w & 0xffff0000u);
                if (d0 < 2) s1 += a0 * a0 + a1 * a1; else s2 += a0 * a0 + a1 * a1;
            }
        const float* km = A.KM + (((VAR == 2 ? 32 : 0) + b) * 4 + h) * 2;
        if (VAR == 0) qkb1 = sqrtf(pair_sum(s1 + s2)) * sqrtf(km[0] + km[1]) * 1.01f;
        else { qkb1 = sqrtf(pair_sum(s1)) * sqrtf(km[0]) * 1.01f; qkb2 = sqrtf(pair_sum(s2)) * sqrtf(km[1]) * 1.01f; }
    }

    ATT_LOAD(0); ATT_STORE(0);
    if (n > 1) ATT_LOAD(1);
    __syncthreads();
    for (int i = 0; i < n; ++i) {
        const int kt = first + i * step, buf = i & 1;
        const bool part = (VAR == 1) ? (kt <= Lw && kt >= Lw - 8) : (kt <= Lw);
        if (part && !wdone) {
            const LAS unsigned char* kb = lds + K_OFF + buf * 8192 + hi * 1024 + r32 * 16;
            const LAS unsigned char* vp = lds + V_OFF + buf * 8192 + ((lane >> 4) & 1) * 32 + (lane & 3) * 8 + (4 * hi + ((lane & 15) >> 2)) * 64;
            const bool diag = (kt == Lw);
            const int tl = t - 64 * kt - 4 * hi;
            if (VAR == 2) {
                const float tb = (float)tl;
#pragma unroll
                for (int mp = 0; mp < 2; ++mp) {
                    f32x16 p0, p1;
#pragma unroll
                    for (int r = 0; r < 16; ++r) { p0[r] = 0.f; p1[r] = 0.f; }
#pragma unroll
                    for (int dd = 0; dd < 2; ++dd) {
                        const int d0 = 2 * mp + dd;
                        const bf16x8 b0 = *(const LAS bf16x8*)(kb + d0 * 2048), b1 = *(const LAS bf16x8*)(kb + d0 * 2048 + 512);
                        p0 = __builtin_amdgcn_mfma_f32_32x32x16_bf16(b0, qr[d0], p0, 0, 0, 0);
                        p1 = __builtin_amdgcn_mfma_f32_32x32x16_bf16(b1, qr[d0], p1, 0, 0, 0);
                    }
#pragma unroll
                    for (int r = 0; r < 16; ++r) {
                        const float c0 = (float)((r & 3) + 8 * (r >> 2));
                        p0[r] = __builtin_fmaf(-slope2, __builtin_fabsf(tb - c0), p0[r]);
                        p1[r] = __builtin_fmaf(-slope2, __builtin_fabsf(tb - (c0 + 32.0f)), p1[r]);
                    }
                    if (mp == 0) softmax_pv(p0, p1, m1, l1, o, wsf, vp, r32, hi);
                    else softmax_pv(p0, p1, m2, l2, o2, wsf, vp, r32, hi);
                    __builtin_amdgcn_sched_barrier(0);
                }
                { const float bf = -slope2 * (float)(tl + 4 * hi + 1);
                  wdone = __all((qkb1 + bf - m1 < -151.0f) && (qkb2 + bf - m2 < -151.0f)); }
            } else {
                f32x16 p0, p1;
#pragma unroll
                for (int r = 0; r < 16; ++r) { p0[r] = 0.f; p1[r] = 0.f; }
#pragma unroll
                for (int d0 = 0; d0 < 4; ++d0) {
                    const bf16x8 b0 = *(const LAS bf16x8*)(kb + d0 * 2048), b1 = *(const LAS bf16x8*)(kb + d0 * 2048 + 512);
                    p0 = __builtin_amdgcn_mfma_f32_32x32x16_bf16(b0, qr[d0], p0, 0, 0, 0);
                    p1 = __builtin_amdgcn_mfma_f32_32x32x16_bf16(b1, qr[d0], p1, 0, 0, 0);
                }
                if (VAR == 0) {
                    const LAS float* fs = FS + buf * 64 + 4 * hi;
#pragma unroll
                    for (int a = 0; a < 4; ++a) {
                        const f32x4 f0 = *(const LAS f32x4*)(fs + 8 * a), f1 = *(const LAS f32x4*)(fs + 32 + 8 * a);
#pragma unroll
                        for (int j = 0; j < 4; ++j) { p0[4 * a + j] += Ft - f0[j]; p1[4 * a + j] += Ft - f1[j]; }
                    }
                    if (diag) {
                        const float tlf = (float)tl;
#pragma unroll
                        for (int r = 0; r < 16; ++r) { const float c0 = (float)((r & 3) + 8 * (r >> 2));
                            p0[r] = __builtin_fmaf(fminf(tlf - c0, 0.f), 1e30f, p0[r]); p1[r] = __builtin_fmaf(fminf(tlf - (c0 + 32.0f), 0.f), 1e30f, p1[r]); }
                    }
                    softmax_pv(p0, p1, m1, l1, o, wsf, vp, r32, hi);
                    wdone = __all(qkb1 + (Ft - FS[buf * 64]) - m1 < -151.0f);
                } else if (VAR == 1) {
                    const LAS float* eb = EXTL + (576 - tl);
#pragma unroll
                    for (int r = 0; r < 16; ++r) { const int c0 = (r & 3) + 8 * (r >> 2); p0[r] += eb[c0]; p1[r] += eb[c0 + 32]; }
                    softmax_pv(p0, p1, m1, l1, o, wsf, vp, r32, hi);
                } else {
                    if (diag) sb_weights<true>(p0, p1, (float)tl, hi, R); else sb_weights<false>(p0, p1, 0.f, hi, R);
                    pv(o, vp, p0, p1);
                    wdone = __all(R == 0.f);
                }
            }
        }
        if (i + 1 < n) ATT_STORE((i + 1) & 1);
        if (i + 2 < n) ATT_LOAD(i + 2);
        if (VAR != 1 && lane == 0) DONE[(i & 1) * 8 + wid] = wdone ? 1u : 0u;
        __syncthreads();
        if (VAR != 1) {
            const u32x4 d0 = *(const LAS u32x4*)(DONE + (i & 1) * 8), d1 = *(const LAS u32x4*)(DONE + (i & 1) * 8 + 4);
            if ((d0[0] & d0[1] & d0[2] & d0[3] & d1[0] & d1[1] & d1[2] & d1[3]) != 0u) break;
        }
    }
#undef ATT_LOAD
#undef ATT_STORE
    bf16_t* op = A.MIX + (rowbase + t) * DM + 256 * VAR + 64 * h + 32 * hi;
    f32x4 x[8];
    if (VAR == 0 || VAR == 1) {
        const float inv = 1.0f / pair_sum(l1);
        o_rows(o, stg, r32, hi, x);
#pragma unroll
        for (int i = 0; i < 8; ++i) x[i] = x[i] * inv;
        store_row(op, x);
    } else if (VAR == 3) {
        o_rows(o, stg, r32, hi, x);
        store_row(op, x);
    } else {
        const float inv1 = 1.0f / pair_sum(l1), inv2 = A.lam / pair_sum(l2);
        f32x4 y[8];
        o_rows(o, stg, r32, hi, x);
        o_rows(o2, stg, r32, hi, y);
        float ss = 0.f;
#pragma unroll
        for (int i = 0; i < 8; ++i) { x[i] = x[i] * inv1 - y[i] * inv2; ss += (x[i][0] * x[i][0] + x[i][1] * x[i][1]) + (x[i][2] * x[i][2] + x[i][3] * x[i][3]); }
        ss = pair_sum(ss);
        const float sc = __builtin_amdgcn_rsqf(ss * (1.0f / 64.0f) + RMS_EPS) * A.one_minus_li;
#pragma unroll
        for (int i = 0; i < 8; ++i) x[i] = x[i] * sc;
        store_row(op, x);
    }
}

__device__ __forceinline__ void attn_phase(LAS unsigned char* lds, const AttnArgs& A, unsigned* ctr, const int tid) {
    volatile LAS unsigned* MISC = (volatile LAS unsigned*)(lds + MISC_OFF);
    if (__builtin_amdgcn_readfirstlane(tid) < 256) __builtin_amdgcn_s_setprio(1);
    if (tid == 0) MISC[0] = atomicAdd(ctr, 1u);
    __syncthreads();
    unsigned u = MISC[0];
    for (int it = 0; u < 4096u; ++it) {
        if (tid == 0) MISC[1 + (it & 1)] = atomicAdd(ctr, 1u);
        int var, qb, bh;
        if (u < 3072u) { qb = 7 - (int)(u / 384u); const int rem = (int)(u % 384u); const int vi = rem >> 7; var = (vi == 0) ? 3 : (vi == 1) ? 2 : 0; bh = rem & 127; }
        else { const int v = (int)u - 3072; var = 1; qb = 7 - (v >> 7); bh = v & 127; }
        const int b = bh >> 2, h = bh & 3;
        int tid_u = tid; asm volatile("" : "+v"(tid_u));
        if (var == 0) attn_unit<0>(lds, A, b, h, qb, tid_u);
        else if (var == 1) attn_unit<1>(lds, A, b, h, qb, tid_u);
        else if (var == 2) attn_unit<2>(lds, A, b, h, qb, tid_u);
        else attn_unit<3>(lds, A, b, h, qb, tid_u);
        u = MISC[1 + (it & 1)];
    }
    __builtin_amdgcn_s_setprio(0);
}
}
using pg8::bf16_t;
typedef float f32x4g __attribute__((ext_vector_type(4)));
typedef unsigned v4u __attribute__((ext_vector_type(4)));
constexpr size_t MiB = 1u << 20;
constexpr size_t WS_CTL = 0, WS_WF = 1 * MiB, WS_LAM = 1 * MiB + 65536, WS_EXT = 1 * MiB + 131072, WS_KM = 1 * MiB + 262144;
constexpr size_t WS_W = 16 * MiB, W_LAYER = 44 * MiB, W_GU1 = 0, W_D1 = 11 * MiB, W_GU2 = 33 * MiB / 2, W_D2 = 55 * MiB / 2, W_IN = 33 * MiB, W_O = 39 * MiB;
constexpr size_t WS_XB = 128 * MiB, WS_SS = 256 * MiB, WS_LFC = 260 * MiB, WS_CT = 261 * MiB, WS_BIG = 272 * MiB, WS_MIX = 656 * MiB, WS_END = 784 * MiB;
constexpr int LDS_BYTES = 163840;
constexpr int LDS_RS = 133120;
constexpr int NWAVES = 8;
#ifndef REP_ATT
#define REP_ATT 1
#endif
#ifndef REP_RES
#define REP_RES 1
#endif
#ifndef REP_IN
#define REP_IN 1
#endif
#ifndef REP_PRO
#define REP_PRO 1
#endif
#ifndef REP_THIN
#define REP_THIN 1
#endif
#ifndef ALIGN_RES
#define ALIGN_RES true
#endif
#ifndef GEMM_SP2
#define GEMM_SP2 true
#endif
#ifndef REP_GU
#define REP_GU 1
#endif

__device__ __forceinline__ unsigned f2bf(float f) { unsigned u = __builtin_bit_cast(unsigned, f); return (u + 0x7fffu + ((u >> 16) & 1u)) >> 16; }
__device__ __forceinline__ unsigned pk2(float lo, float hi) { return f2bf(lo) | (f2bf(hi) << 16); }
__device__ __forceinline__ float wave_sum(float v) {
#pragma unroll
    for (int o = 1; o < 64; o <<= 1) v += __shfl_xor(v, o);
    return v;
}
__device__ __forceinline__ void transpose_item(const float* W, int K, int Nsrc, bf16_t* WT, const float* g, int n0, int c0, int k0, LAS float* scr, int lane) {
    float tv[32];
#pragma unroll
    for (int i = 0; i < 32; ++i) { const int kk = 2 * i + (lane >> 5); tv[i] = __builtin_nontemporal_load(W + (size_t)(k0 + kk) * Nsrc + c0 + (lane & 31)); }
    const float gl = g ? g[k0 + lane] : 1.0f;
#pragma unroll
    for (int i = 0; i < 32; ++i) { const int kk = 2 * i + (lane >> 5); scr[kk * 33 + (lane & 31)] = tv[i] * __shfl(gl, kk); }
    asm volatile("s_waitcnt lgkmcnt(0)" ::: "memory");
    const int c = lane & 7;
#pragma unroll
    for (int j = 0; j < 4; ++j) { const int nn = (lane >> 3) + 8 * j; const LAS float* s = scr + (8 * c) * 33 + nn;
        v4u o; o.x = pk2(s[0 * 33], s[1 * 33]); o.y = pk2(s[2 * 33], s[3 * 33]); o.z = pk2(s[4 * 33], s[5 * 33]); o.w = pk2(s[6 * 33], s[7 * 33]);
        *(v4u*)(WT + (size_t)(n0 + nn) * K + k0 + 8 * c) = o; }
    asm volatile("s_waitcnt lgkmcnt(0)" ::: "memory");
}
__device__ __forceinline__ int map_col(int mode, int n) {
    if (mode == 1) { const int tt = n >> 8, w = n & 255; return (w < 128) ? 128 * tt + w : DFF + 128 * tt + (w - 128); }
    if (mode == 2) return n < 768 ? n : n + 4;
    return n;
}
__device__ __forceinline__ void transpose_matrix(const float* W, int K, int Nsrc, int Ndst, bf16_t* WT, const float* g, int mode, int item, LAS float* scr, int lane) {
    const int nblk = Ndst / 32, kb = item / nblk, nb = item % nblk;
    transpose_item(W, K, Nsrc, WT, g, 32 * nb, map_col(mode, 32 * nb), 64 * kb, scr, lane);
}

#define XB_TMO      128
#define XB_XCNT(j)  (256  + 64 * (j))
#define XB_XSUB(j)  (1280 + 64 * (j))
#define XB_XGEN(j)  (2304 + 64 * (j))
#define XB_TOP      3328
#define XB_TOPGEN   3392
#define XCD_BAR_WORDS 3456
#define XB_SPIN_CAP (1u << 18)

__device__ __forceinline__ unsigned xb_ld(unsigned* p)              { return __hip_atomic_load(p, __ATOMIC_RELAXED, __HIP_MEMORY_SCOPE_AGENT); }
__device__ __forceinline__ unsigned xb_add(unsigned* p, unsigned v) { return __hip_atomic_fetch_add(p, v, __ATOMIC_RELAXED, __HIP_MEMORY_SCOPE_AGENT); }
__device__ __forceinline__ unsigned xb_xcc_id() { return (unsigned)__builtin_amdgcn_s_getreg((3 << 11) | 20) & 0xFu; }
#define XB_SPIN(cond, bar) do { unsigned _sp = 0; while (cond) { __builtin_amdgcn_s_sleep(1); \
    if ((++_sp & 255u) == 0u) { if (xb_ld(&(bar)[XB_TMO])) break; if (_sp > XB_SPIN_CAP) { atomicAdd(&(bar)[XB_TMO], 1u); break; } } } } while (0)

struct XcdBarrier {
    unsigned* bar; unsigned x;
    volatile LAS unsigned* st;
};

__device__ __forceinline__ XcdBarrier xcd_barrier_post(unsigned* bar, volatile LAS unsigned* st) {
    XcdBarrier b; b.bar = bar; b.x = xb_xcc_id(); b.st = st;
    if (threadIdx.x == 0) (void)xb_add(&bar[XB_XCNT(b.x)], 1u);
    return b;
}
__device__ __forceinline__ void xcd_barrier_complete(unsigned* bar, unsigned x, unsigned& nloc, unsigned& nx) {
    const unsigned G = gridDim.x * gridDim.y * gridDim.z;
    unsigned sum, cnt, mine, sp = 0u;
    for (;;) {
        sum = 0u; cnt = 0u; mine = 0u;
#pragma unroll
        for (unsigned j = 0; j < 16; ++j) { const unsigned c = xb_ld(&bar[XB_XCNT(j)]); sum += c; cnt += (c > 0u) ? 1u : 0u; mine = (j == x) ? c : mine; }
        if (sum == G) break;
        __builtin_amdgcn_s_sleep(1);
        if ((++sp & 255u) == 0u) { if (xb_ld(&bar[XB_TMO])) break; if (sp > XB_SPIN_CAP) { atomicAdd(&bar[XB_TMO], 1u); break; } }
    }
    nloc = mine > 0u ? mine : 1u; nx = cnt > 0u ? cnt : 1u;
}

__device__ __forceinline__ void xcd_barrier(const XcdBarrier& b) {
    asm volatile("s_waitcnt vmcnt(0)" ::: "memory");
    __syncthreads();
    if (threadIdx.x == 0) {
        unsigned* bar = b.bar;
        __builtin_amdgcn_s_waitcnt(0);
        unsigned nloc = b.st[0], nx = b.st[1];
        if (nloc == 0u) { xcd_barrier_complete(bar, b.x, nloc, nx); b.st[0] = nloc; b.st[1] = nx; }
        const unsigned old = xb_add(&bar[XB_XSUB(b.x)], 1u);
        const unsigned gen = old / nloc;
        if (old + 1u == (gen + 1u) * nloc) {
            __builtin_amdgcn_fence(__ATOMIC_RELEASE, "agent");
            asm volatile("s_waitcnt vmcnt(0)" ::: "memory");
            const unsigned og = xb_add(&bar[XB_TOP], 1u);
            const unsigned tg = og / nx;
            if (og + 1u == (tg + 1u) * nx) xb_add(&bar[XB_TOPGEN], 1u);
            else XB_SPIN(xb_ld(&bar[XB_TOPGEN]) == tg, bar);
            __builtin_amdgcn_fence(__ATOMIC_ACQUIRE, "agent");
            xb_add(&bar[XB_XGEN(b.x)], 1u);
            asm volatile("s_waitcnt vmcnt(0)" ::: "memory");
        } else {
            XB_SPIN(xb_ld(&bar[XB_XGEN(b.x)]) == gen, bar);
            __builtin_amdgcn_fence(__ATOMIC_ACQUIRE, "agent");
            asm volatile("s_waitcnt vmcnt(0)" ::: "memory");
        }
    }
    __syncthreads();
}

constexpr int CW_BAR = 4096;
constexpr int LDS_BARST = 131072 + 64;
struct Params { const float* in[14]; float* out; unsigned char* ws; };

typedef __attribute__((address_space(4))) const Params* KP;
__device__ __forceinline__ KP kparams() {
    auto p = (const __attribute__((address_space(4))) unsigned char*)__builtin_amdgcn_kernarg_segment_ptr();
    asm volatile("" : "+s"(p)); return (KP)p;
}
#define PH_COMMON const KP kp = kparams(); unsigned char* const ws = kp->ws; int tid_ = threadIdx.x; asm volatile("" : "+v"(tid_)); const int tid = tid_, lane = tid & 63, wave = __builtin_amdgcn_readfirstlane(tid >> 6); const int G = gridDim.x; (void)ws; (void)lane; (void)wave; (void)G;

__global__ void __launch_bounds__(512, 2) fwd_kernel(Params Punused) {
    extern __shared__ __attribute__((aligned(16))) unsigned char lds_raw[];
    LAS unsigned char* lds = (LAS unsigned char*)lds_raw;
    cg::grid_group grid = cg::this_grid();
    volatile LAS unsigned* const barst = (volatile LAS unsigned*)(lds + LDS_BARST);
    if (threadIdx.x < 2) barst[threadIdx.x] = 0u;
    if (blockIdx.x == 0) { unsigned* bw = (unsigned*)(kparams()->ws + WS_CTL) + CW_BAR; for (int i = threadIdx.x; i < XCD_BAR_WORDS; i += 512) bw[i] = 0u; }
#define GRID_BAR() do { XcdBarrier b_; b_.bar = (unsigned*)(kparams()->ws + WS_CTL) + CW_BAR; b_.x = xb_xcc_id(); b_.st = barst; xcd_barrier(b_); } while (0)

    for (int rep_ = 0; rep_ < REP_PRO; ++rep_) {
        PH_COMMON
        const int gw = blockIdx.x * NWAVES + wave, NGW = G * NWAVES;
        LAS float* scr = (LAS float*)(lds + wave * 16384);
        constexpr int I_GU = (DM / 64) * (NGU / 32), I_D = (DFF / 64) * (DM / 32), I_IN = (DM / 64) * (NIN / 32), I_O = (DM / 64) * (DM / 32);
        constexpr int I_LAYER = 2 * I_GU + 2 * I_D + I_IN + I_O;
        for (int it = gw; it < 2 * I_LAYER; it += NGW) {
            const int l = it / I_LAYER; int r = it % I_LAYER;
            unsigned char* wl = ws + WS_W + (size_t)l * W_LAYER;
            if (r < I_GU) { transpose_matrix(kp->in[2] + (size_t)l * DM * NGU, DM, NGU, NGU, (bf16_t*)(wl + W_GU1), kp->in[1] + l * DM, 1, r, scr, lane); continue; } r -= I_GU;
            if (r < I_GU) { transpose_matrix(kp->in[11] + (size_t)l * DM * NGU, DM, NGU, NGU, (bf16_t*)(wl + W_GU2), kp->in[10] + l * DM, 1, r, scr, lane); continue; } r -= I_GU;
            if (r < I_D) { transpose_matrix(kp->in[3] + (size_t)l * DFF * DM, DFF, DM, DM, (bf16_t*)(wl + W_D1), nullptr, 0, r, scr, lane); continue; } r -= I_D;
            if (r < I_D) { transpose_matrix(kp->in[12] + (size_t)l * DFF * DM, DFF, DM, DM, (bf16_t*)(wl + W_D2), nullptr, 0, r, scr, lane); continue; } r -= I_D;
            if (r < I_IN) { transpose_matrix(kp->in[5] + (size_t)l * DM * INW, DM, INW, NIN, (bf16_t*)(wl + W_IN), kp->in[4] + l * DM, 2, r, scr, lane); continue; } r -= I_IN;
            transpose_matrix(kp->in[9] + (size_t)l * DM * DM, DM, DM, DM, (bf16_t*)(wl + W_O), nullptr, 0, r, scr, lane);
        }
        const float* x_in = kp->in[0]; bf16_t* XB = (bf16_t*)(ws + WS_XB); float* SS = (float*)(ws + WS_SS);
        for (int m0 = gw * 4; m0 < MROWS; m0 += NGW * 4) {
            f32x4g v[4][4]; float s[4];
#pragma unroll
            for (int q = 0; q < 4; ++q) { const f32x4g* xr = (const f32x4g*)(x_in + (size_t)(m0 + q) * DM) + lane;
#pragma unroll
                for (int j = 0; j < 4; ++j) v[q][j] = __builtin_nontemporal_load(xr + 64 * j); }
#pragma unroll
            for (int q = 0; q < 4; ++q) { s[q] = 0.f;
#pragma unroll
                for (int j = 0; j < 4; ++j) s[q] += (v[q][j][0] * v[q][j][0] + v[q][j][1] * v[q][j][1]) + (v[q][j][2] * v[q][j][2] + v[q][j][3] * v[q][j][3]);
                s[q] = wave_sum(s[q]); }
#pragma unroll
            for (int q = 0; q < 4; ++q) {
                unsigned long long* o8 = (unsigned long long*)(XB + (size_t)(m0 + q) * DM) + lane;
#pragma unroll
                for (int j = 0; j < 4; ++j) o8[64 * j] = (unsigned long long)pk2(v[q][j][0], v[q][j][1]) | ((unsigned long long)pk2(v[q][j][2], v[q][j][3]) << 32);
            }
            { const int q = lane >> 4; const float sq = q == 0 ? s[0] : q == 1 ? s[1] : q == 2 ? s[2] : s[3]; SS[(size_t)m0 * 16 + lane] = ((lane & 15) == 0) ? sq : 0.f; }
        }
        float* WF = (float*)(ws + WS_WF); float* LAM = (float*)(ws + WS_LAM); float* EXT = (float*)(ws + WS_EXT); unsigned* CTL = (unsigned*)(ws + WS_CTL);
        const int gt = blockIdx.x * 512 + tid, NGT = G * 512;
        for (int i = gt; i < 2 * 4 * DM; i += NGT) { const int l = i / (4 * DM), hh = (i / DM) & 3, k = i % DM; WF[i] = kp->in[4][l * DM + k] * kp->in[5][((size_t)l * DM + k) * INW + 768 + hh]; }
        for (int i = gt; i < 2 * 512; i += NGT) ((unsigned*)(ws + WS_KM))[i] = 0u;
        for (int i = gt; i < 2 * 4 * 640; i += NGT) { const int lh = i / 640, j = i % 640; int d = 576 - j; d = d < -256 ? -256 : (d > 256 ? 256 : d); EXT[i] = kp->in[7][lh * NREL + d + 256] * LOG2E; }
        if (blockIdx.x == 0 && tid < 2) {
            const float* lp = kp->in[8] + tid * 128; float a = 0.f, b2 = 0.f;
            for (int i = 0; i < 32; ++i) { a += lp[i] * lp[32 + i]; b2 += lp[64 + i] * lp[96 + i]; }
            const float li = 0.8f - 0.6f * expf(-0.3f * (float)tid);
            LAM[tid * 2] = expf(a) - expf(b2) + li; LAM[tid * 2 + 1] = 1.0f - li;
            CTL[64 * tid] = 0u; CTL[64 * (tid + 2)] = 0u;
        }
    }
    grid.sync();
    (void)xcd_barrier_post((unsigned*)(kparams()->ws + WS_CTL) + CW_BAR, barst);

    for (int st = 0; st < 6; ++st) {
        const int l = st / 3, k = st % 3;
        if (k != 1) {
            {
                PH_COMMON
                unsigned char* wl = ws + WS_W + (size_t)l * W_LAYER;
                pg8::Gemm g{(const bf16_t*)(ws + WS_XB), (const bf16_t*)(wl + (k == 0 ? W_GU1 : W_GU2)), MROWS, NGU, DM}; pg8::StaticOrder S; S.init(MROWS, NGU, G, (int)blockIdx.x);
                pg8::EpiGU E{(bf16_t*)(ws + WS_BIG), (const float*)(ws + WS_SS), lds + LDS_RS};
                S.rep = REP_GU; pg8::gemm_phase<pg8::EpiGU, pg8::StaticOrder, true, GEMM_SP2>(lds, g, S, E, tid);
            }
            GRID_BAR();
        } else {
            {
                PH_COMMON
                const bf16_t* XBr = (const bf16_t*)(ws + WS_XB); float* LFC = (float*)(ws + WS_LFC); float* CT = (float*)(ws + WS_CT);
                LAS float* lfs = (LAS float*)lds;
                const float* wf = (const float*)(ws + WS_WF) + l * 4 * DM;
                f32x4g w[4][4];
#pragma unroll
                for (int hh = 0; hh < 4; ++hh)
#pragma unroll
                    for (int j = 0; j < 4; ++j) w[hh][j] = *(const f32x4g*)(wf + hh * DM + 512 * (j >> 1) + 8 * lane + 4 * (j & 1));
                const float bfv = kp->in[6][l * 4 + (lane & 3)];
                for (int rep_ = 0; rep_ < REP_THIN; ++rep_)
                for (int ch = blockIdx.x; ch < MROWS / 256; ch += G) {
                    for (int rr = 0; rr < 32; rr += 4) {
                        const int rl = wave * 32 + rr; const size_t m = (size_t)ch * 256 + rl;
                        v4u xv[4][2];
#pragma unroll
                        for (int q = 0; q < 4; ++q)
#pragma unroll
                            for (int j = 0; j < 2; ++j) xv[q][j] = *(const v4u*)(XBr + (m + q) * DM + 512 * j + 8 * lane);
#pragma unroll
                        for (int q = 0; q < 4; ++q) {
                            float s = 0.f, d[4] = {0.f, 0.f, 0.f, 0.f};
#pragma unroll
                            for (int j = 0; j < 4; ++j) {
                                const unsigned u0 = xv[q][j >> 1][2 * (j & 1)], u1 = xv[q][j >> 1][2 * (j & 1) + 1];
                                const float a0 = __uint_as_float(u0 << 16), a1 = __uint_as_float(u0 & 0xffff0000u), a2 = __uint_as_float(u1 << 16), a3 = __uint_as_float(u1 & 0xffff0000u);
                                s += (a0 * a0 + a1 * a1) + (a2 * a2 + a3 * a3);
#pragma unroll
                                for (int hh = 0; hh < 4; ++hh) d[hh] += (a0 * w[hh][j][0] + a1 * w[hh][j][1]) + (a2 * w[hh][j][2] + a3 * w[hh][j][3]);
                            }
                            s = wave_sum(s);
#pragma unroll
                            for (int hh = 0; hh < 4; ++hh) d[hh] = wave_sum(d[hh]);
                            const float rs = 1.0f / sqrtf(s * (1.0f / DM) + RMS_EPS);
                            const float dsel = (lane & 3) == 0 ? d[0] : (lane & 3) == 1 ? d[1] : (lane & 3) == 2 ? d[2] : d[3];
                            const float z = dsel * rs + bfv;
                            const float lf = fminf(z, 0.f) - log1pf(expf(-fabsf(z)));
                            if (lane < 4) lfs[(rl + q) * 4 + lane] = lf * LOG2E;
                        }
                    }
                    __syncthreads();
                    if (wave < 4) {
                        const int hh = wave; float v0 = lfs[(4 * lane) * 4 + hh], v1 = lfs[(4 * lane + 1) * 4 + hh], v2 = lfs[(4 * lane + 2) * 4 + hh], v3 = lfs[(4 * lane + 3) * 4 + hh];
                        v1 += v0; v2 += v1; v3 += v2;
                        float inc = v3;
#pragma unroll
                        for (int o = 1; o < 64; o <<= 1) { const float tq = __shfl_up(inc, o); if (lane >= o) inc += tq; }
                        const float ex = inc - v3;
                        float* dst = LFC + ((size_t)ch * 256 + 4 * lane) * 4 + hh;
                        dst[0] = ex + v0; dst[4] = ex + v1; dst[8] = ex + v2; dst[12] = ex + v3;
                        if (lane == 63) CT[ch * 4 + hh] = inc;
                    }
                    __syncthreads();
                }
            }
            {
                PH_COMMON
                unsigned char* wl = ws + WS_W + (size_t)l * W_LAYER;
                pg8::Gemm g{(const bf16_t*)(ws + WS_XB), (const bf16_t*)(wl + W_IN), MROWS, NIN, DM}; pg8::StaticOrder S; S.init(MROWS, NIN, G, (int)blockIdx.x);
                pg8::EpiQKV E{(bf16_t*)(ws + WS_BIG), (const float*)(ws + WS_SS), lds + LDS_RS, (unsigned*)(ws + WS_KM) + 512 * l};
                S.rep = REP_IN; pg8::gemm_phase<pg8::EpiQKV, pg8::StaticOrder, true, GEMM_SP2>(lds, g, S, E, tid);
            }
            GRID_BAR();
            {
                PH_COMMON
                const float* LAM = (const float*)(ws + WS_LAM);
                att::AttnArgs A{(const bf16_t*)(ws + WS_BIG), (bf16_t*)(ws + WS_MIX), (const float*)(ws + WS_LFC), (const float*)(ws + WS_CT), (const float*)(ws + WS_EXT) + l * 4 * 640, (const float*)(ws + WS_KM) + 512 * l, LAM[2 * l], LAM[2 * l + 1]};
                for (int rep = 0; rep < REP_ATT; ++rep) att::attn_phase(lds, A, (unsigned*)(ws + WS_CTL) + 64 * (l + 2 * rep), tid);
            }
            GRID_BAR();
        }
        {
            PH_COMMON
            unsigned char* wl = ws + WS_W + (size_t)l * W_LAYER;
            pg8::Gemm g = (k != 1) ? pg8::Gemm{(const bf16_t*)(ws + WS_BIG), (const bf16_t*)(wl + (k == 0 ? W_D1 : W_D2)), MROWS, DM, DFF} : pg8::Gemm{(const bf16_t*)(ws + WS_MIX), (const bf16_t*)(wl + W_O), MROWS, DM, DM};
            pg8::StaticOrder S; S.init(MROWS, DM, G, (int)blockIdx.x);
            pg8::EpiRes E{(bf16_t*)(ws + WS_XB), (float*)(ws + WS_SS), (k != 1) ? 0.5f : 1.0f};
            S.rep = REP_RES; pg8::gemm_phase<pg8::EpiRes, pg8::StaticOrder, ALIGN_RES, GEMM_SP2>(lds, g, S, E, tid);
        }
        GRID_BAR();
    }
#ifdef EXTRA_SYNCS
    for (int i = 0; i < EXTRA_SYNCS; ++i) GRID_BAR();
#endif
    {
        PH_COMMON
        const int gw = blockIdx.x * NWAVES + wave, NGW = G * NWAVES;
        float* OUT = kp->out; const bf16_t* XBr = (const bf16_t*)(ws + WS_XB);
        const float* gf = kp->in[13];
        f32x4g gv[4];
#pragma unroll
        for (int j = 0; j < 4; ++j) gv[j] = *(const f32x4g*)(gf + 512 * (j >> 1) + 8 * lane + 4 * (j & 1));
        for (int rep_ = 0; rep_ < REP_THIN; ++rep_)
        for (int m0 = gw * 4; m0 < MROWS; m0 += NGW * 4) {
            v4u xv[4][2];
#pragma unroll
            for (int q = 0; q < 4; ++q)
#pragma unroll
                for (int j = 0; j < 2; ++j) xv[q][j] = __builtin_nontemporal_load((const v4u*)(XBr + (size_t)(m0 + q) * DM + 512 * j + 8 * lane));
#pragma unroll
            for (int q = 0; q < 4; ++q) {
                f32x4g v[4]; float s = 0.f;
#pragma unroll
                for (int j = 0; j < 4; ++j) {
                    const unsigned u0 = xv[q][j >> 1][2 * (j & 1)], u1 = xv[q][j >> 1][2 * (j & 1) + 1];
                    v[j] = (f32x4g){__uint_as_float(u0 << 16), __uint_as_float(u0 & 0xffff0000u), __uint_as_float(u1 << 16), __uint_as_float(u1 & 0xffff0000u)};
                    s += (v[j][0] * v[j][0] + v[j][1] * v[j][1]) + (v[j][2] * v[j][2] + v[j][3] * v[j][3]);
                }
                s = wave_sum(s);
                const float rs = 1.0f / sqrtf(s * (1.0f / DM) + RMS_EPS);
                float* orow = OUT + (size_t)(m0 + q) * DM;
#pragma unroll
                for (int j = 0; j < 4; ++j) __builtin_nontemporal_store(v[j] * rs * gv[j], (f32x4g*)(orow + 512 * (j >> 1) + 8 * lane + 4 * (j & 1)));
            }
        }
    }
}

extern "C" void kernel_launch(void* const* d_in, const int* in_sizes, int n_in, void* d_out, int out_size, void* d_ws, size_t ws_size, hipStream_t stream) {
    static int grid = 0;
    if (grid == 0) {
        if (n_in != 14 || in_sizes[0] != MROWS * DM || out_size != MROWS * DM || ws_size < WS_END) {
            fprintf(stderr, "kernel_launch: unexpected problem (n_in %d, in0 %d, out %d, ws %zu); nothing launched\n", n_in, n_in > 0 ? in_sizes[0] : -1, out_size, ws_size); grid = -1; return; }
        int dev = 0, cus = 0, per_cu = 0;
        (void)hipGetDevice(&dev);
        (void)hipDeviceGetAttribute(&cus, hipDeviceAttributeMultiprocessorCount, dev);
        if (hipFuncSetAttribute((const void*)fwd_kernel, hipFuncAttributeMaxDynamicSharedMemorySize, LDS_BYTES) != hipSuccess) fprintf(stderr, "kernel_launch: hipFuncSetAttribute failed\n");
        if (hipOccupancyMaxActiveBlocksPerMultiprocessor(&per_cu, (const void*)fwd_kernel, 512, LDS_BYTES) != hipSuccess || per_cu < 1) { fprintf(stderr, "kernel_launch: occupancy query gave %d\n", per_cu); per_cu = 1; }
        (void)hipGetLastError();
        grid = cus * per_cu;
        fprintf(stderr, "kernel_launch: grid %d (%d CUs x %d)\n", grid, cus, per_cu);
    }
    if (grid < 0) return;
    Params p{};
    for (int i = 0; i < 14; ++i) p.in[i] = (const float*)d_in[i];
    p.out = (float*)d_out; p.ws = (unsigned char*)d_ws;
    void* args[] = {&p};
    hipError_t e = hipLaunchCooperativeKernel((const void*)fwd_kernel, dim3(grid), dim3(512), args, LDS_BYTES, stream);
    if (e != hipSuccess) fprintf(stderr, "kernel_launch: cooperative launch failed: %s (grid %d)\n", hipGetErrorString(e), grid);
}
```
